# Optimizing an MI355X kernel written in HIP

```python
import math
import jax, jax.numpy as jnp
from jax import lax
import numpy as np

D_MODEL = 1024
BATCH = 8
SEQ = 4096
DEPTH = 2

D_MIX = 2 * D_MODEL
SSM_W = D_MIX // 4
SSM_GROUP_CH = 16
SSM_GROUPS = SSM_W // SSM_GROUP_CH
SSM_STATE = 64
SSM_STEP_MIN = 1e-3
SSM_STEP_MAX = 1e-1
SGU_W = D_MIX // 4
CHUNK = 128
SGU_HEADS = 4
SGU_HEAD_W = SGU_W // SGU_HEADS
ATT_W = D_MIX // 2
ATT_HEAD_D = 64
ATT_HEADS = ATT_W // (2 * ATT_HEAD_D)
Q_BLOCK = 128
IN_SIZES = (SSM_W, SSM_W,
            SGU_W, SGU_W, SGU_W,
            ATT_W, ATT_W, ATT_W, ATT_W)
IN_COLS = sum(IN_SIZES)
NORM_EPS = 1e-6
LN_EPS = 1e-5

kernel_name = "hybrid_s5_sgu_diffattn_parallel_heads"


def rms_norm(x, g):
    xf = x.astype(jnp.float32)
    y = xf * lax.rsqrt(jnp.mean(xf * xf, axis=-1, keepdims=True) + NORM_EPS)
    return (y * g.astype(jnp.float32)).astype(x.dtype)


def layer_norm(x, g, b):
    xf = x.astype(jnp.float32)
    mu = jnp.mean(xf, axis=-1, keepdims=True)
    var = jnp.mean(jnp.square(xf - mu), axis=-1, keepdims=True)
    y = (xf - mu) * lax.rsqrt(var + LN_EPS)
    return (y * g.astype(jnp.float32) + b.astype(jnp.float32)).astype(x.dtype)


def _complex_affine_combine(e1, e2):
    a1r, a1i, b1r, b1i = e1
    a2r, a2i, b2r, b2i = e2
    ar = a2r * a1r - a2i * a1i
    ai = a2r * a1i + a2i * a1r
    br = a2r * b1r - a2i * b1i + b2r
    bi = a2r * b1i + a2i * b1r + b2i
    return (ar, ai, br, bi)


def s5_mixer(u, a_re, a_im, log_step, b_re, b_im, c_re, c_im, d_skip, glu_w, glu_b):
    bsz, seq, _ = u.shape
    f32 = jnp.float32
    uf = u.astype(f32).reshape(bsz, seq, SSM_GROUPS, SSM_GROUP_CH)
    lr = a_re.astype(f32)
    li = a_im.astype(f32)
    step = jnp.exp(log_step.astype(f32))[:, None]
    mag = jnp.exp(step * lr)
    ang = step * li
    ab_re = mag * jnp.cos(ang)
    ab_im = mag * jnp.sin(ang)
    den = lr * lr + li * li
    nr = ab_re - 1.0
    ni = ab_im
    co_re = (nr * lr + ni * li) / den
    co_im = (ni * lr - nr * li) / den
    br = b_re.astype(f32)
    bi = b_im.astype(f32)
    bb_re = co_re[..., None] * br - co_im[..., None] * bi
    bb_im = co_re[..., None] * bi + co_im[..., None] * br
    bu_re = jnp.einsum('blgh,gph->blgp', uf, bb_re)
    bu_im = jnp.einsum('blgh,gph->blgp', uf, bb_im)
    ar = jnp.broadcast_to(ab_re, bu_re.shape)
    ai = jnp.broadcast_to(ab_im, bu_im.shape)
    _, _, s_re, s_im = lax.associative_scan(_complex_affine_combine, (ar, ai, bu_re, bu_im), axis=1)
    y = (jnp.einsum('blgp,ghp->blgh', s_re, c_re.astype(f32))
         - jnp.einsum('blgp,ghp->blgh', s_im, c_im.astype(f32))
         + d_skip.astype(f32).reshape(SSM_GROUPS, SSM_GROUP_CH) * uf)
    y = y.reshape(bsz, seq, SSM_W)
    y = jax.nn.gelu(y, approximate=False)
    y = y * jax.nn.sigmoid(y @ glu_w.astype(f32) + glu_b.astype(f32))
    return y.astype(u.dtype)


def sgu_mixer(u, v, ln_g, ln_b, w_s, b_s):
    bsz, seq, _ = u.shape
    nc = seq // CHUNK
    vn = layer_norm(v, ln_g, ln_b).reshape(bsz, nc, CHUNK, SGU_HEADS, SGU_HEAD_W)
    causal = jnp.tril(jnp.ones((CHUNK, CHUNK), dtype=bool))
    w = jnp.where(causal[None], w_s, jnp.zeros_like(w_s))
    s = jnp.einsum('hts,bcshe->bcthe', w, vn) + b_s.T[:, :, None]
    return u * s.reshape(bsz, seq, SGU_W)


def diff_attention(q, k, v, lam, lam_init, subln_g):
    bsz, seq, nh, _, hd = q.shape
    nb = seq // Q_BLOCK
    qb = q.reshape(bsz, nb, Q_BLOCK, nh, 2, hd).transpose(1, 0, 2, 3, 4, 5)
    kpos = jnp.arange(seq)
    scale = hd ** -0.5
    neg = jnp.finfo(jnp.float32).min

    def block(args):
        qi, start = args
        s = jnp.einsum('bqhcd,bkhcd->bhcqk', qi.astype(jnp.float32), k.astype(jnp.float32)) * scale
        qpos = start + jnp.arange(Q_BLOCK)
        mask = kpos[None, :] <= qpos[:, None]
        p = jax.nn.softmax(jnp.where(mask, s, neg), axis=-1)
        wmap = p[:, :, 0] - lam * p[:, :, 1]
        return jnp.einsum('bhqk,bkhe->bqhe', wmap.astype(v.dtype), v)

    starts = jnp.arange(nb) * Q_BLOCK
    o = lax.map(block, (qb, starts))
    o = o.transpose(1, 0, 2, 3, 4).reshape(bsz, seq, nh, 2 * hd)
    o = rms_norm(o, subln_g) * (1.0 - lam_init)
    return o.reshape(bsz, seq, nh * 2 * hd)


def setup_inputs(seed: int = 0) -> dict:
    key = jax.random.key(seed)
    ks = jax.random.split(key, 24)
    f32 = jnp.float32
    nrm = lambda k, s: jax.random.normal(k, s, dtype=f32)
    n_idx = jnp.arange(SSM_STATE, dtype=f32)
    return {
        "x": nrm(ks[0], (BATCH, SEQ, D_MODEL)),
        "norm_g": 1.0 + 0.02 * nrm(ks[1], (DEPTH, D_MODEL)),
        "w_in": nrm(ks[2], (DEPTH, D_MODEL, IN_COLS)) * D_MODEL ** -0.5,
        "ssm_a_re": -0.5 + 0.01 * nrm(ks[3], (DEPTH, SSM_GROUPS, SSM_STATE)),
        "ssm_a_im": math.pi * n_idx + 0.01 * nrm(ks[4], (DEPTH, SSM_GROUPS, SSM_STATE)),
        "ssm_log_step": jax.random.uniform(ks[5], (DEPTH, SSM_GROUPS), dtype=f32,
                                           minval=math.log(SSM_STEP_MIN), maxval=math.log(SSM_STEP_MAX)),
        "ssm_b_re": nrm(ks[6], (DEPTH, SSM_GROUPS, SSM_STATE, SSM_GROUP_CH)) * (2 * SSM_GROUP_CH) ** -0.5,
        "ssm_b_im": nrm(ks[7], (DEPTH, SSM_GROUPS, SSM_STATE, SSM_GROUP_CH)) * (2 * SSM_GROUP_CH) ** -0.5,
        "ssm_c_re": nrm(ks[8], (DEPTH, SSM_GROUPS, SSM_GROUP_CH, SSM_STATE)) * SSM_STATE ** -0.5,
        "ssm_c_im": nrm(ks[9], (DEPTH, SSM_GROUPS, SSM_GROUP_CH, SSM_STATE)) * SSM_STATE ** -0.5,
        "ssm_d": nrm(ks[10], (DEPTH, SSM_W)),
        "glu_w": nrm(ks[11], (DEPTH, SSM_W, SSM_W)) * SSM_W ** -0.5,
        "glu_b": 0.01 * nrm(ks[12], (DEPTH, SSM_W)),
        "sgu_ln_g": 1.0 + 0.02 * nrm(ks[13], (DEPTH, SGU_W)),
        "sgu_ln_b": 0.01 * nrm(ks[14], (DEPTH, SGU_W)),
        "sgu_w": nrm(ks[15], (DEPTH, SGU_HEADS, CHUNK, CHUNK)) * 0.5 * CHUNK ** -0.5,
        "sgu_b": 1.0 + 0.01 * nrm(ks[16], (DEPTH, SGU_HEADS, CHUNK)),
        "lam_q1": 0.1 * nrm(ks[17], (DEPTH, ATT_HEAD_D)),
        "lam_k1": 0.1 * nrm(ks[18], (DEPTH, ATT_HEAD_D)),
        "lam_q2": 0.1 * nrm(ks[19], (DEPTH, ATT_HEAD_D)),
        "lam_k2": 0.1 * nrm(ks[20], (DEPTH, ATT_HEAD_D)),
        "attn_subln_g": 1.0 + 0.02 * nrm(ks[21], (DEPTH, 2 * ATT_HEAD_D)),
        "w_out": nrm(ks[22], (DEPTH, D_MIX, D_MODEL)) * D_MIX ** -0.5,
        "final_g": 1.0 + 0.02 * nrm(ks[23], (D_MODEL,)),
    }


def reference(x, norm_g, w_in, ssm_a_re, ssm_a_im, ssm_log_step, ssm_b_re, ssm_b_im,
              ssm_c_re, ssm_c_im, ssm_d, glu_w, glu_b, sgu_ln_g, sgu_ln_b, sgu_w, sgu_b,
              lam_q1, lam_k1, lam_q2, lam_k2, attn_subln_g, w_out, final_g):
    bsz, seq, _ = x.shape
    split_at = [sum(IN_SIZES[:i + 1]) for i in range(len(IN_SIZES) - 1)]
    for l in range(DEPTH):
        h = rms_norm(x, norm_g[l])
        z = h @ w_in[l]
        (s_in, s_gate, g_u, g_v, g_gate, a_q, a_k, a_v, a_gate) = jnp.split(z, split_at, axis=-1)

        y_ssm = s5_mixer(s_in, ssm_a_re[l], ssm_a_im[l], ssm_log_step[l], ssm_b_re[l], ssm_b_im[l],
                         ssm_c_re[l], ssm_c_im[l], ssm_d[l], glu_w[l], glu_b[l])
        y_ssm = y_ssm * jax.nn.silu(s_gate)

        y_sgu = sgu_mixer(g_u, g_v, sgu_ln_g[l], sgu_ln_b[l], sgu_w[l], sgu_b[l])
        y_sgu = y_sgu * jax.nn.silu(g_gate)

        lam_init = 0.8 - 0.6 * math.exp(-0.3 * l)
        lam = (jnp.exp(jnp.sum(lam_q1[l].astype(jnp.float32) * lam_k1[l].astype(jnp.float32)))
               - jnp.exp(jnp.sum(lam_q2[l].astype(jnp.float32) * lam_k2[l].astype(jnp.float32)))
               + lam_init)
        q = a_q.reshape(bsz, seq, ATT_HEADS, 2, ATT_HEAD_D)
        k = a_k.reshape(bsz, seq, ATT_HEADS, 2, ATT_HEAD_D)
        v = a_v.reshape(bsz, seq, ATT_HEADS, 2 * ATT_HEAD_D)
        y_att = diff_attention(q, k, v, lam, lam_init, attn_subln_g[l])
        y_att = y_att * jax.nn.silu(a_gate)

        mix = jnp.concatenate([y_ssm, y_sgu, y_att], axis=-1)
        x = x + mix @ w_out[l]
    return rms_norm(x, final_g)
```

```cpp
#include <hip/hip_runtime.h>
#include <hip/hip_cooperative_groups.h>
#include <cstdio>
#include <cstdint>
namespace cg = cooperative_groups;

#define LAS __attribute__((address_space(3)))
typedef unsigned short bf16_t;
typedef short bf16x8 __attribute__((ext_vector_type(8)));
typedef float f32x4 __attribute__((ext_vector_type(4)));
typedef float f32x16 __attribute__((ext_vector_type(16)));
typedef unsigned u32x4 __attribute__((ext_vector_type(4)));
typedef unsigned u32x2 __attribute__((ext_vector_type(2)));
typedef float f32x2_t __attribute__((ext_vector_type(2)));
typedef __bf16 bf16x2_t __attribute__((ext_vector_type(2)));

__device__ __forceinline__ unsigned pk2(float lo, float hi) { f32x2_t v = {lo, hi}; bf16x2_t b = __builtin_convertvector(v, bf16x2_t); return __builtin_bit_cast(unsigned, b); }
__device__ __forceinline__ float bflo(unsigned u) { return __uint_as_float(u << 16); }
__device__ __forceinline__ float bfhi(unsigned u) { return __uint_as_float(u & 0xffff0000u); }
__device__ __forceinline__ bf16_t f2bf(float f) { return (bf16_t)(pk2(f, 0.f) & 0xffffu); }
__device__ __forceinline__ float siluf(float x) { return x / (1.f + __expf(-x)); }
__device__ __forceinline__ float sigmf(float x) { return 1.f / (1.f + __expf(-x)); }
__device__ __forceinline__ float wave_sum(float v) {
#pragma unroll
    for (int o = 1; o < 64; o <<= 1) v += __shfl_xor(v, o);
    return v;
}
#define MFMA16(a, b, c) __builtin_amdgcn_mfma_f32_16x16x32_bf16((a), (b), (c), 0, 0, 0)
#define MFMA32(a, b, c) __builtin_amdgcn_mfma_f32_32x32x16_bf16((a), (b), (c), 0, 0, 0)

constexpr int T_TOK = 32768, DM = 1024, SEQ = 4096, NBATCH = 8, ZP = 5632, NIN = 6656, DMIX = 2048;
constexpr int C_SGATE = 0, C_GU = 512, C_Q = 1024, C_SIN = 2048, C_GV = 2560, C_GGATE = 3072, C_K = 3584, C_AGATE = 4608;
constexpr float C2 = 0.125f * 1.4426950408889634f;
constexpr size_t OFF_Z = 0, SZ_Z = (size_t)T_TOK * ZP * 2;
constexpr size_t OFF_VT = OFF_Z + SZ_Z, SZ_VT = (size_t)T_TOK * 1024 * 2;
constexpr size_t OFF_XB = OFF_VT + SZ_VT, SZ_XB = (size_t)T_TOK * 1024 * 2;
constexpr size_t OFF_WIN = OFF_XB + SZ_XB, SZ_WIN = (size_t)NIN * 1024 * 2;
constexpr size_t OFF_WOUT = OFF_WIN + SZ_WIN, SZ_WOUT = (size_t)1024 * 2048 * 2;
constexpr size_t OFF_GLU = OFF_WOUT + SZ_WOUT, SZ_GLU = (size_t)2 * 512 * 512 * 2;
constexpr size_t OFF_KC = OFF_GLU + SZ_GLU, SZ_KC = (size_t)64 * 4096 * 2;
constexpr size_t OFF_CCH = OFF_KC + SZ_KC, SZ_CCH = (size_t)64 * 32768 * 2;
constexpr size_t OFF_BCH = OFF_CCH + SZ_CCH, SZ_BCH = (size_t)64 * 32768 * 2;
constexpr size_t OFF_A16 = OFF_BCH + SZ_BCH, SZ_A16 = (size_t)64 * 64 * 8;
constexpr size_t OFF_PART = OFF_A16 + SZ_A16, SZ_PART = (size_t)T_TOK * 16 * 4;
constexpr size_t OFF_SGUW = OFF_PART + SZ_PART, SZ_SGUW = (size_t)2 * 4 * 128 * 128 * 2;
constexpr size_t OFF_LAM = OFF_SGUW + SZ_SGUW, OFF_BAR = OFF_LAM + 256, WS_END = OFF_BAR + 16384;
constexpr int LDS_BYTES = 147456;

namespace pg8 {
constexpr int BM = 256, BK = 64, HALF = 128, HTB = HALF * BK * 2, STAGE_BYTES = 8 * HTB, NXCD = 8, WGM = 8;
__host__ __device__ __forceinline__ int lds_byte(int r, int c) { const int st = (r >> 4) * 2 + (c >> 5), rr = r & 15, cc = c & 31, ob = rr * 64 + cc * 2; return st * 1024 + (ob ^ (((ob >> 9) & 1) << 5)); }
__host__ __device__ __forceinline__ void stage_rc(int b, int& R, int& C) { const int st = b / 1024, sb = b % 1024, swz = sb ^ (((sb >> 9) & 1) << 5); R = (st >> 1) * 16 + swz / 64; C = (st & 1) * 32 + (swz % 64) / 2; }
__host__ __device__ __forceinline__ int perm32(int rho) { const int n = rho >> 4, i = rho & 15; return 8 * (i >> 2) + 4 * n + (i & 3); }
__host__ __device__ __forceinline__ int permV(int rho) { const int n = rho >> 4, i = rho & 15, q = i >> 2, j = i & 3; return 16 * (q >> 1) + 8 * n + 4 * (q & 1) + j; }
struct Unit { int pm, pn; };
struct Gemm { const bf16_t* A; const bf16_t* Bt; int M, N, K, lda, ldb; };
struct StaticOrder {
    int nM, nN, nwg, G, c;
    __device__ void init(int M, int N, int G_, int c_) { nM = M / BM; nN = N / BM; nwg = nM * nN; G = G_; c = c_; }
    __device__ bool next(int i, Unit& u) const {
        const long L = (long)i * G + c; if (L >= nwg) return false;
        int wgid = (int)L; { const int q = nwg / NXCD, r = nwg % NXCD, xcd = wgid % NXCD, off = wgid / NXCD; wgid = (xcd < r ? xcd * (q + 1) : r * (q + 1) + (xcd - r) * q) + off; }
        const int nig = WGM * nN, gid = wgid / nig, fm = gid * WGM, gsz = (nM - fm) < WGM ? (nM - fm) : WGM;
        u.pm = fm + ((wgid % nig) % gsz); u.pn = (wgid % nig) / gsz; return true;
    }
};
template <class Epi>
__device__ __forceinline__ void gemm_phase(LAS unsigned char* lds, const Gemm g, const StaticOrder& S, const Epi& E) {
    int tid = threadIdx.x; asm volatile("" : "+v"(tid));
    const int wid = __builtin_amdgcn_readfirstlane(tid >> 6), lane = tid & 63, wr = wid >> 2, wc = wid & 3, fr = lane & 15, fq = lane >> 4;
    const int K = g.K, nt = K / BK;
    unsigned voffA[2], voffB[2];
#pragma unroll
    for (int i = 0; i < 2; ++i) { int R, C; stage_rc(tid * 16 + i * 8192, R, C);
        const int Rb = (Epi::PERM == 1) ? ((R & ~31) + perm32(R & 31)) : (Epi::PERM == 2) ? ((R & ~31) + permV(R & 31)) : R;
        voffA[i] = (unsigned)(R * g.lda + C) * 2u; voffB[i] = (unsigned)(Rb * g.ldb + C) * 2u; }
    const size_t kstep = (size_t)(BK * 2);
    const size_t hstepA = (size_t)HALF * g.lda * 2, hstepB = (size_t)HALF * g.ldb * 2;
    const size_t tstepA = 2 * hstepA, tstepB = 2 * hstepB;
    const unsigned ldsw = (unsigned)wid * 1024u;
    const int aoff = lds_byte(wr * 64 + fr, fq * 8), boff = lds_byte(wc * 32 + fr, fq * 8);
#define PG8_SA(b, h) (((b) * 2 + (h)) * HTB)
#define PG8_SB(b, h) ((4 + (b) * 2 + (h)) * HTB)
#define PG8_STAGE(bufoff, gbase, voff) do { _Pragma("unroll") for (int _i = 0; _i < 2; ++_i) \
        __builtin_amdgcn_global_load_lds((const unsigned*)((const char*)(gbase) + (voff)[_i]), (LAS unsigned*)(lds + (bufoff) + ldsw + _i * 8192), 16, 0, 0); } while (0)
#define PG8_LDA(dst, b, h) do { _Pragma("unroll") for (int m = 0; m < 4; ++m) _Pragma("unroll") for (int k = 0; k < 2; ++k) dst[m][k] = *(const LAS bf16x8*)(lds + PG8_SA(b, h) + aoff + m * 2048 + k * 1024); } while (0)
#define PG8_LDB(dst, b, h) do { _Pragma("unroll") for (int n = 0; n < 2; ++n) _Pragma("unroll") for (int k = 0; k < 2; ++k) dst[n][k] = *(const LAS bf16x8*)(lds + PG8_SB(b, h) + boff + n * 2048 + k * 1024); } while (0)
#define PG8_MMA(ai, bj, At, Bt) do { __builtin_amdgcn_s_setprio(1); _Pragma("unroll") for (int m = 0; m < 4; ++m) _Pragma("unroll") for (int n = 0; n < 2; ++n) _Pragma("unroll") for (int k = 0; k < 2; ++k) \
        acc[ai][bj][m][n] = __builtin_amdgcn_mfma_f32_16x16x32_bf16(Bt[n][k], At[m][k], acc[ai][bj][m][n], 0, 0, 0); __builtin_amdgcn_s_setprio(0); } while (0)
#define PG8_WAIT_V(n) asm volatile("s_waitcnt vmcnt(" #n ")" ::: "memory")
#define PG8_WAIT_L(n) asm volatile("s_waitcnt lgkmcnt(" #n ")" ::: "memory")
#define PG8_BAR __builtin_amdgcn_s_barrier()
#define PG8_SCHED __builtin_amdgcn_sched_barrier(0)
    Unit cur, nxt; int ui = 0;
    if (!S.next(0, cur)) return;
    f32x4 acc[2][2][4][2];
#pragma unroll
    for (int a = 0; a < 2; ++a)
#pragma unroll
        for (int b = 0; b < 2; ++b)
#pragma unroll
            for (int m = 0; m < 4; ++m)
#pragma unroll
                for (int n = 0; n < 2; ++n) acc[a][b][m][n] = (f32x4){0.f, 0.f, 0.f, 0.f};
    bf16x8 At[4][2], B0[2][2], B1[2][2];
    const char* cA = (const char*)g.A + (size_t)cur.pm * tstepA; const char* cB = (const char*)g.Bt + (size_t)cur.pn * tstepB;
    PG8_STAGE(PG8_SB(0, 0), cB, voffB); PG8_STAGE(PG8_SB(0, 1), cB + hstepB, voffB); PG8_STAGE(PG8_SA(0, 0), cA, voffA); PG8_STAGE(PG8_SA(0, 1), cA + hstepA, voffA);
    if (wr == 1) PG8_BAR;
    PG8_WAIT_V(2); PG8_BAR;
    PG8_STAGE(PG8_SB(1, 0), cB + kstep, voffB); PG8_STAGE(PG8_SA(1, 0), cA + kstep, voffA); PG8_STAGE(PG8_SB(1, 1), cB + hstepB + kstep, voffB);
    PG8_WAIT_V(6); PG8_BAR;
    for (;;) {
        const bool has_next = S.next(ui + 1, nxt);
        const char* nA = has_next ? (const char*)g.A + (size_t)nxt.pm * tstepA : cA; const char* nB = has_next ? (const char*)g.Bt + (size_t)nxt.pn * tstepB : cB;
        for (int t = 0; t < nt; t += 2) {
            const bool last = (t == nt - 2);
            const char* a1 = cA + (size_t)(t + 1) * kstep;
            const char* a2 = last ? nA : cA + (size_t)(t + 2) * kstep; const char* b2 = last ? nB : cB + (size_t)(t + 2) * kstep;
            const char* a3 = a2 + kstep; const char* b3 = b2 + kstep;
            PG8_LDB(B0, 0, 0); PG8_LDB(B1, 0, 1); PG8_SCHED; PG8_LDA(At, 0, 0); PG8_STAGE(PG8_SA(1, 1), a1 + hstepA, voffA);
            PG8_WAIT_V(8); PG8_WAIT_L(0); PG8_BAR; PG8_MMA(0, 0, At, B0); PG8_MMA(0, 1, At, B1); PG8_BAR; PG8_SCHED;
            PG8_LDA(At, 0, 1); PG8_STAGE(PG8_SB(0, 0), b2, voffB); PG8_STAGE(PG8_SB(0, 1), b2 + hstepB, voffB); PG8_STAGE(PG8_SA(0, 0), a2, voffA);
            PG8_WAIT_V(8); PG8_WAIT_L(0); PG8_BAR; PG8_MMA(1, 0, At, B0); PG8_MMA(1, 1, At, B1); PG8_BAR; PG8_SCHED;
            PG8_LDB(B0, 1, 0); PG8_LDB(B1, 1, 1); PG8_SCHED; PG8_LDA(At, 1, 0); PG8_STAGE(PG8_SA(0, 1), a2 + hstepA, voffA);
            PG8_WAIT_V(8); PG8_WAIT_L(0); PG8_BAR; PG8_MMA(0, 0, At, B0); PG8_MMA(0, 1, At, B1); PG8_BAR; PG8_SCHED;
            PG8_LDA(At, 1, 1); PG8_STAGE(PG8_SB(1, 0), b3, voffB); PG8_STAGE(PG8_SB(1, 1), b3 + hstepB, voffB); PG8_STAGE(PG8_SA(1, 0), a3, voffA);
            PG8_WAIT_V(8); PG8_WAIT_L(0); PG8_BAR; PG8_MMA(1, 0, At, B0); PG8_MMA(1, 1, At, B1); PG8_BAR; PG8_SCHED;
        }
        if (wr == 0) PG8_BAR;
        E(acc, cur, wr, wc, fr, fq);
        if (!has_next) break;
#pragma unroll
        for (int a = 0; a < 2; ++a)
#pragma unroll
            for (int b = 0; b < 2; ++b)
#pragma unroll
                for (int m = 0; m < 4; ++m)
#pragma unroll
                    for (int n = 0; n < 2; ++n) acc[a][b][m][n] = (f32x4){0.f, 0.f, 0.f, 0.f};
        cur = nxt; cA = nA; cB = nB; ++ui;
        if (wr == 1) PG8_BAR;
    }
    PG8_WAIT_V(0);
    PG8_BAR;
#undef PG8_SA
#undef PG8_SB
#undef PG8_STAGE
#undef PG8_LDA
#undef PG8_LDB
#undef PG8_MMA
#undef PG8_WAIT_V
#undef PG8_WAIT_L
#undef PG8_BAR
#undef PG8_SCHED
}
}

typedef f32x4 AccT[2][2][4][2];
__device__ __forceinline__ float row_rinv(const float* part, int row) {
    const f32x4* p = (const f32x4*)(part + (size_t)row * 16);
    const f32x4 a = p[0], b = p[1], c = p[2], d = p[3];
    const float s = ((a[0] + a[1]) + (a[2] + a[3])) + ((b[0] + b[1]) + (b[2] + b[3])) + ((c[0] + c[1]) + (c[2] + c[3])) + ((d[0] + d[1]) + (d[2] + d[3]));
    return rsqrtf(s * (1.f / 1024.f) + 1e-6f);
}
struct EpiIn {
    static constexpr int PERM = 1;
    bf16_t* Z; const float* part;
    __device__ __forceinline__ void operator()(const AccT& acc, const pg8::Unit& u, int wr, int wc, int fr, int fq) const {
        const float qs = (u.pn >= 4 && u.pn < 8) ? C2 : 1.f;
#pragma unroll
        for (int ai = 0; ai < 2; ++ai)
#pragma unroll
            for (int m = 0; m < 4; ++m) {
                const int row = u.pm * 256 + ai * 128 + wr * 64 + m * 16 + fr;
                const float sc = row_rinv(part, row) * qs;
                bf16_t* rp = Z + (size_t)row * ZP + u.pn * 256 + wc * 32 + 8 * fq;
#pragma unroll
                for (int bj = 0; bj < 2; ++bj) { const f32x4 v0 = acc[ai][bj][m][0] * sc, v1 = acc[ai][bj][m][1] * sc;
                    u32x4 w; w.x = pk2(v0[0], v0[1]); w.y = pk2(v0[2], v0[3]); w.z = pk2(v1[0], v1[1]); w.w = pk2(v1[2], v1[3]);
                    __builtin_nontemporal_store(w, (u32x4*)(rp + bj * 128)); }
            }
    }
};
struct EpiVT {
    static constexpr int PERM = 2;
    bf16_t* VT; const float* part;
    __device__ __forceinline__ void operator()(const AccT& acc, const pg8::Unit& u, int wr, int wc, int fr, int fq) const {
#pragma unroll
        for (int bj = 0; bj < 2; ++bj) {
            const int g32 = u.pn * 256 + bj * 128 + wc * 32;
            const int t0 = g32 + 16 * (fq >> 1) + 4 * (fq & 1);
            f32x4 r0, r1;
            r0[0] = row_rinv(part, t0); r0[1] = row_rinv(part, t0 + 1); asm volatile("" : "+v"(r0[0]), "+v"(r0[1]));
            r0[2] = row_rinv(part, t0 + 2); r0[3] = row_rinv(part, t0 + 3); asm volatile("" : "+v"(r0[2]), "+v"(r0[3]));
            r1[0] = row_rinv(part, t0 + 8); r1[1] = row_rinv(part, t0 + 9); asm volatile("" : "+v"(r1[0]), "+v"(r1[1]));
            r1[2] = row_rinv(part, t0 + 10); r1[3] = row_rinv(part, t0 + 11); asm volatile("" : "+v"(r1[2]), "+v"(r1[3]));
            const int b = g32 >> 12, tp = (g32 & 4095) + 16 * (fq >> 1) + 8 * (fq & 1);
#pragma unroll
            for (int ai = 0; ai < 2; ++ai)
#pragma unroll
                for (int m = 0; m < 4; ++m) { const int ch = u.pm * 256 + ai * 128 + wr * 64 + m * 16 + fr;
                    const f32x4 v0 = acc[ai][bj][m][0] * r0, v1 = acc[ai][bj][m][1] * r1;
                    u32x4 w; w.x = pk2(v0[0], v0[1]); w.y = pk2(v0[2], v0[3]); w.z = pk2(v1[0], v1[1]); w.w = pk2(v1[2], v1[3]);
                    __builtin_nontemporal_store(w, (u32x4*)(VT + ((size_t)(b * 1024 + ch)) * SEQ + tp)); }
        }
    }
};
struct EpiGlu {
    static constexpr int PERM = 0;
    bf16_t* Z; const float* gb;
    __device__ __forceinline__ void operator()(const AccT& acc, const pg8::Unit& u, int wr, int wc, int fr, int fq) const {
#pragma unroll
        for (int ai = 0; ai < 2; ++ai)
#pragma unroll
            for (int m = 0; m < 4; ++m) {
                const int row = u.pm * 256 + ai * 128 + wr * 64 + m * 16 + fr;
#pragma unroll
                for (int bj = 0; bj < 2; ++bj)
#pragma unroll
                    for (int n = 0; n < 2; ++n) { const int col = u.pn * 256 + bj * 128 + wc * 32 + n * 16 + 4 * fq;
                        bf16_t* zp = Z + (size_t)row * ZP + col;
                        const u32x2 yp = *(const u32x2*)(zp + C_SIN), gt = *(const u32x2*)(zp + C_SGATE);
                        const f32x4 bb = *(const f32x4*)(gb + col); const f32x4 a = acc[ai][bj][m][n] + bb;
                        const float o0 = bflo(yp.x) * sigmf(a[0]) * siluf(bflo(gt.x)), o1 = bfhi(yp.x) * sigmf(a[1]) * siluf(bfhi(gt.x));
                        const float o2 = bflo(yp.y) * sigmf(a[2]) * siluf(bflo(gt.y)), o3 = bfhi(yp.y) * sigmf(a[3]) * siluf(bfhi(gt.y));
                        u32x2 w; w.x = pk2(o0, o1); w.y = pk2(o2, o3); *(u32x2*)(zp + C_SGATE) = w; }
            }
    }
};
template <bool LAST> struct EpiOut {
    static constexpr int PERM = 1;
    const float* xold; float* out; bf16_t* XB; float* part;
    __device__ __forceinline__ void operator()(const AccT& acc, const pg8::Unit& u, int wr, int wc, int fr, int fq) const {
#pragma unroll
        for (int ai = 0; ai < 2; ++ai)
#pragma unroll
            for (int m = 0; m < 4; ++m) {
                const int row = u.pm * 256 + ai * 128 + wr * 64 + m * 16 + fr; float ss = 0.f;
#pragma unroll
                for (int bj = 0; bj < 2; ++bj)
#pragma unroll
                    for (int n = 0; n < 2; ++n) { const size_t o = (size_t)row * DM + u.pn * 256 + bj * 128 + wc * 32 + 8 * fq + 4 * n;
                        const f32x4 xn = __builtin_nontemporal_load((const f32x4*)(xold + o)) + acc[ai][bj][m][n];
                        __builtin_nontemporal_store(xn, (f32x4*)(out + o)); if (!LAST) { u32x2 w; w.x = pk2(xn[0], xn[1]); w.y = pk2(xn[2], xn[3]); *(u32x2*)(XB + o) = w; }
                        ss += (xn[0] * xn[0] + xn[1] * xn[1]) + (xn[2] * xn[2] + xn[3] * xn[3]); }
                ss += __shfl_xor(ss, 16); ss += __shfl_xor(ss, 32);
                if (fq == 0) part[(size_t)row * 16 + u.pn * 4 + wc] = ss;
            }
    }
};

__device__ __forceinline__ int remap_col(int n) {
    if (n < 512) return 512 + n;
    if (n < 1024) return 1024 + (n - 512);
    if (n < 2048) return 2560 + (n - 1024);
    if (n < 2560) return n - 2048;
    if (n < 3072) return 1536 + (n - 2560);
    if (n < 3584) return 2048 + (n - 3072);
    if (n < 4608) return n;
    if (n < 5632) return 5632 + (n - 4608);
    return 4608 + (n - 5632);
}
__device__ __forceinline__ void transpose_item(const float* W, int K, int N, int srcn0, const float* kscale, bf16_t* WT, int dstrow0, LAS float* scr, int k0, int lane) {
    asm volatile("" : "+v"(lane));
#pragma unroll 8
    for (int i = 0; i < 32; ++i) { const int kk = 2 * i + (lane >> 5); float v = W[(size_t)(k0 + kk) * N + srcn0 + (lane & 31)]; if (kscale) v *= kscale[k0 + kk]; scr[kk * 33 + (lane & 31)] = v; }
    asm volatile("s_waitcnt lgkmcnt(0)" ::: "memory");
    const int c = lane & 7;
#pragma unroll
    for (int j = 0; j < 4; ++j) { const int n = (lane >> 3) + 8 * j; const LAS float* s = scr + (8 * c) * 33 + n;
        u32x4 o; o.x = pk2(s[0 * 33], s[1 * 33]); o.y = pk2(s[2 * 33], s[3 * 33]); o.z = pk2(s[4 * 33], s[5 * 33]); o.w = pk2(s[6 * 33], s[7 * 33]);
        *(u32x4*)(WT + (size_t)(dstrow0 + n) * K + k0 + 8 * c) = o; }
    asm volatile("s_waitcnt lgkmcnt(0)" ::: "memory");
}
__device__ __forceinline__ void conv_win(LAS unsigned char* lds, const float* w_in_l, const float* g_l, bf16_t* WinT, int gw, int NGW, int wid, int lane) {
    LAS float* scr = (LAS float*)(lds + wid * 8448);
    for (int it = gw; it < 16 * 208; it += NGW) { const int kb = it / 208, nb = it % 208; transpose_item(w_in_l, 1024, NIN, remap_col(32 * nb), g_l, WinT, 32 * nb, scr, 64 * kb, lane); }
}
__device__ __forceinline__ void conv_plain(LAS unsigned char* lds, const float* W, int K, int N, bf16_t* WT, int gw, int NGW, int wid, int lane) {
    LAS float* scr = (LAS float*)(lds + wid * 8448);
    const int nbn = N / 32, nit = (K / 64) * nbn;
    for (int it = gw; it < nit; it += NGW) { const int kb = it / nbn, nb = it % nbn; transpose_item(W, K, N, 32 * nb, nullptr, WT, 32 * nb, scr, 64 * kb, lane); }
}
struct S5In { const float *a_re, *a_im, *lstep, *b_re, *b_im, *c_re, *c_im, *d; };
__device__ __forceinline__ void s5_params(LAS unsigned char* lds, const S5In& I, int lg, bf16_t* KcO, bf16_t* CchO, bf16_t* BchO, float* A16O, int tid) {
    asm volatile("" : "+v"(tid));
    typedef float f2 __attribute__((ext_vector_type(2)));
    LAS f2* pw = (LAS f2*)lds;
    LAS f2* Bb = (LAS f2*)(lds + 8704);
    LAS f2* Cc = (LAS f2*)(lds + 16896);
    if (tid < 64) {
        const int p = tid; const float lr = I.a_re[lg * 64 + p], li = I.a_im[lg * 64 + p], step = expf(I.lstep[lg]);
        const float mag = expf(step * lr), ang = step * li; float sn, cs; sincosf(ang, &sn, &cs);
        const float abr = mag * cs, abi = mag * sn;
        f2 w = {1.f, 0.f}; pw[p] = w;
#pragma unroll 1
        for (int t = 1; t <= 16; ++t) { const f2 n = {w.x * abr - w.y * abi, w.x * abi + w.y * abr}; w = n; pw[t * 64 + p] = w; }
        A16O[(lg * 64 + p) * 2] = w.x; A16O[(lg * 64 + p) * 2 + 1] = w.y;
        const float den = lr * lr + li * li, nr = abr - 1.f, ni = abi;
        const float cor = (nr * lr + ni * li) / den, coi = (ni * lr - nr * li) / den;
#pragma unroll 1
        for (int h = 0; h < 16; ++h) { const float br = I.b_re[(lg * 64 + p) * 16 + h], bi = I.b_im[(lg * 64 + p) * 16 + h]; const f2 v = {cor * br - coi * bi, cor * bi + coi * br}; Bb[p * 16 + h] = v; }
    }
#pragma unroll 1
    for (int i = tid; i < 1024; i += 512) { const f2 v = {I.c_re[lg * 1024 + i], I.c_im[lg * 1024 + i]}; Cc[i] = v; }
    __syncthreads();
#pragma unroll 1
    for (int e = tid; e < 4096; e += 512) { const int t = e >> 8, h = (e >> 4) & 15, h2 = e & 15; float a = 0.f;
#pragma unroll 4
        for (int p = 0; p < 64; ++p) { const f2 w = pw[t * 64 + p], cc = Cc[h * 64 + p], bb = Bb[p * 16 + h2]; const float tr = cc.x * w.x - cc.y * w.y, ti = cc.x * w.y + cc.y * w.x; a += tr * bb.x - ti * bb.y; }
        if (t == 0 && h == h2) a += I.d[(lg >> 5) * 512 + (lg & 31) * 16 + h];
        KcO[(size_t)lg * 4096 + e] = f2bf(a); }
#pragma unroll 2
    for (int e = tid; e < 32768; e += 512) { const int r = e >> 7, p2 = e & 127, t = r >> 4, h = r & 15, p = p2 & 63;
        const f2 w = pw[(t + 1) * 64 + p], cc = Cc[h * 64 + p]; const float Wr = cc.x * w.x - cc.y * w.y, Wi = cc.x * w.y + cc.y * w.x;
        CchO[(size_t)lg * 32768 + e] = f2bf(p2 < 64 ? Wr : -Wi); }
#pragma unroll 2
    for (int e = tid; e < 32768; e += 512) { const int p2 = e >> 8, k = e & 255, j = k >> 4, h2 = k & 15, p = p2 & 63;
        const f2 w = pw[(15 - j) * 64 + p], bb = Bb[p * 16 + h2]; const float Gr = w.x * bb.x - w.y * bb.y, Gi = w.x * bb.y + w.y * bb.x;
        BchO[(size_t)lg * 32768 + e] = f2bf(p2 < 64 ? Gr : Gi); }
    __syncthreads();
}

__device__ __forceinline__ float gelu_exact(float y) { return 0.5f * y * (1.f + erff(y * 0.70710678118654752f)); }
template <bool ST> __device__ __forceinline__ void s5_unit(LAS unsigned char* lds, bf16_t* Z, const bf16_t* Kc, const bf16_t* Cch, const bf16_t* Bch, const float* A16, int b, int g, int wid, int lane) {
    asm volatile("" : "+v"(lane));
    const int fr = lane & 15, fq = lane >> 4;
    LAS float* S = (LAS float*)lds;
    const size_t tokb = (size_t)b * SEQ;
    bf16x8 uf[2][8];
#pragma unroll
    for (int n2 = 0; n2 < 2; ++n2)
#pragma unroll
        for (int ks = 0; ks < 8; ++ks) { const int c = 16 * (2 * wid + n2) + fr;
            uf[n2][ks] = *(const bf16x8*)(Z + (tokb + 16 * c + 2 * ks + (fq >> 1)) * ZP + C_SIN + 16 * g + 8 * (fq & 1)); }
#pragma unroll 2
    for (int mt = 0; mt < 8; ++mt) {
        f32x4 a0 = {0.f, 0.f, 0.f, 0.f}, a1 = {0.f, 0.f, 0.f, 0.f};
#pragma unroll
        for (int ks = 0; ks < 8; ++ks) { const bf16x8 a = *(const bf16x8*)(Bch + (16 * mt + fr) * 256 + 32 * ks + 8 * fq); a0 = MFMA16(a, uf[0][ks], a0); a1 = MFMA16(a, uf[1][ks], a1); }
        *(LAS f32x4*)(S + (16 * (2 * wid) + fr) * 128 + 16 * mt + 4 * fq) = a0;
        *(LAS f32x4*)(S + (16 * (2 * wid + 1) + fr) * 128 + 16 * mt + 4 * fq) = a1;
    }
    __syncthreads();
    u32x4 cpre[8]; u32x4 kpre;
    { const int tid_ = wid * 64 + lane;
#pragma unroll
      for (int i = 0; i < 8; ++i) { const int q = tid_ + 512 * i; cpre[i] = *(const u32x4*)(Cch + (q >> 4) * 128 + (q & 15) * 8); }
      kpre = *(const u32x4*)(Kc + tid_ * 8); }
    if (wid == 0) {
        const int p = lane; const float ar = A16[2 * p], ai = A16[2 * p + 1]; float hr = 0.f, hi = 0.f;
        float sr[8], si[8], tr[8], ti[8];
#pragma unroll
        for (int j = 0; j < 8; ++j) { sr[j] = S[j * 128 + p]; si[j] = S[j * 128 + 64 + p]; }
#pragma unroll 1
        for (int c0 = 0; c0 < 256; c0 += 8) {
            const int cn = (c0 + 8 < 256) ? c0 + 8 : c0;
#pragma unroll
            for (int j = 0; j < 8; ++j) { tr[j] = S[(cn + j) * 128 + p]; ti[j] = S[(cn + j) * 128 + 64 + p]; }
            asm volatile("s_waitcnt lgkmcnt(0)" ::: "memory");
#pragma unroll
            for (int j = 0; j < 8; ++j) {
                LAS bf16_t* Hrow = (LAS bf16_t*)(S + (c0 + j) * 128);
                Hrow[p] = f2bf(hr); Hrow[64 + p] = f2bf(hi);
                const float nr = ar * hr - ai * hi + sr[j], ni = ar * hi + ai * hr + si[j]; hr = nr; hi = ni;
            }
            asm volatile("" ::: "memory");
#pragma unroll
            for (int j = 0; j < 8; ++j) { sr[j] = tr[j]; si[j] = ti[j]; }
        }
    }
    __syncthreads();
    { const int tid_ = wid * 64 + lane;
#pragma unroll
      for (int i = 0; i < 8; ++i) { const int q = tid_ + 512 * i; *(LAS u32x4*)((LAS unsigned char*)S + (q >> 4) * 512 + 256 + (q & 15) * 16) = cpre[i]; }
      *(LAS u32x4*)(lds + 131072 + tid_ * 16) = kpre; }
    __syncthreads();
    bf16x8 hf[2][4];
#pragma unroll
    for (int n2 = 0; n2 < 2; ++n2)
#pragma unroll
        for (int ks = 0; ks < 4; ++ks) { const int c = 16 * (2 * wid + n2) + fr; hf[n2][ks] = *(const LAS bf16x8*)((const LAS unsigned char*)S + c * 512 + (32 * ks + 8 * fq) * 2); }
#define S5_LDA(kk, cc, t_) do { _Pragma("unroll") for (int ks = 0; ks <= ((t_) >> 1); ++ks) { const int jt = 2 * ks + (fq >> 1); const int tau = (t_) - jt; \
            kk[ks] = *(const LAS bf16x8*)(lds + 131072 + (((tau < 0 ? 0 : tau) * 16 + fr) * 16 + 8 * (fq & 1)) * 2); if (tau < 0) kk[ks] = (bf16x8){0, 0, 0, 0, 0, 0, 0, 0}; } \
        _Pragma("unroll") for (int ks = 0; ks < 4; ++ks) cc[ks] = *(const LAS bf16x8*)((const LAS unsigned char*)S + (16 * (t_) + fr) * 512 + 256 + (32 * ks + 8 * fq) * 2); } while (0)
    bf16x8 kcur[8], ccur[4];
    S5_LDA(kcur, ccur, 0);
#pragma unroll
    for (int t = 0; t < 16; ++t) {
        bf16x8 knx[8], cnx[4];
        if (t + 1 < 16) S5_LDA(knx, cnx, t + 1);
        f32x4 a0 = {0.f, 0.f, 0.f, 0.f}, a1 = {0.f, 0.f, 0.f, 0.f};
#pragma unroll
        for (int ks = 0; ks <= (t >> 1); ++ks) { a0 = MFMA16(kcur[ks], uf[0][ks], a0); a1 = MFMA16(kcur[ks], uf[1][ks], a1); }
#pragma unroll
        for (int ks = 0; ks < 4; ++ks) { a0 = MFMA16(ccur[ks], hf[0][ks], a0); a1 = MFMA16(ccur[ks], hf[1][ks], a1); }
        { const int c = 16 * (2 * wid) + fr; u32x2 w; w.x = pk2(gelu_exact(a0[0]), gelu_exact(a0[1])); w.y = pk2(gelu_exact(a0[2]), gelu_exact(a0[3]));
          if (ST) *(u32x2*)(Z + (tokb + 16 * c + t) * ZP + C_SIN + 16 * g + 4 * fq) = w; else *(LAS u32x2*)(lds + 139264 + lane * 16) = w; }
        { const int c = 16 * (2 * wid + 1) + fr; u32x2 w; w.x = pk2(gelu_exact(a1[0]), gelu_exact(a1[1])); w.y = pk2(gelu_exact(a1[2]), gelu_exact(a1[3]));
          if (ST) *(u32x2*)(Z + (tokb + 16 * c + t) * ZP + C_SIN + 16 * g + 4 * fq) = w; else *(LAS u32x2*)(lds + 139264 + lane * 16 + 8) = w; }
        if (t + 1 < 16) {
#pragma unroll
            for (int ks = 0; ks <= ((t + 1) >> 1); ++ks) kcur[ks] = knx[ks];
#pragma unroll
            for (int ks = 0; ks < 4; ++ks) ccur[ks] = cnx[ks]; }
    }
#undef S5_LDA
    __syncthreads();
}

template <bool ST> __device__ __forceinline__ void sgu_unit(LAS unsigned char* lds, bf16_t* Z, const bf16_t* Wm, const float* lng, const float* lnb, const float* bs, int b, int ch, int hd, int wid, int lane) {
    asm volatile("" : "+v"(lane));
    const size_t tok0 = (size_t)b * SEQ + (size_t)ch * 128;
    LAS bf16_t* vT = (LAS bf16_t*)lds;
    const int fr = lane & 15, fq = lane >> 4;
    {
        const int tt = lane >> 2, part = lane & 3, t = 16 * wid + tt;
        const bf16_t* rowp = Z + (tok0 + t) * ZP + C_GV + part * 8;
        u32x4 raw[16], hv[4];
#pragma unroll
        for (int jj = 0; jj < 16; ++jj) raw[jj] = *(const u32x4*)(rowp + jj * 32);
#pragma unroll
        for (int jj = 0; jj < 4; ++jj) hv[jj] = *(const u32x4*)(rowp + (4 * hd + jj) * 32);
        float s = 0.f;
#pragma unroll
        for (int jj = 0; jj < 16; ++jj) s += ((bflo(raw[jj].x) + bfhi(raw[jj].x)) + (bflo(raw[jj].y) + bfhi(raw[jj].y))) + ((bflo(raw[jj].z) + bfhi(raw[jj].z)) + (bflo(raw[jj].w) + bfhi(raw[jj].w)));
        s += __shfl_xor(s, 1); s += __shfl_xor(s, 2);
        const float mu = s * (1.f / 512.f); float q = 0.f;
#pragma unroll
        for (int jj = 0; jj < 16; ++jj) { float d;
            d = bflo(raw[jj].x) - mu; q += d * d; d = bfhi(raw[jj].x) - mu; q += d * d; d = bflo(raw[jj].y) - mu; q += d * d; d = bfhi(raw[jj].y) - mu; q += d * d;
            d = bflo(raw[jj].z) - mu; q += d * d; d = bfhi(raw[jj].z) - mu; q += d * d; d = bflo(raw[jj].w) - mu; q += d * d; d = bfhi(raw[jj].w) - mu; q += d * d; }
        q += __shfl_xor(q, 1); q += __shfl_xor(q, 2);
        const float rstd = rsqrtf(q * (1.f / 512.f) + 1e-5f);
#pragma unroll
        for (int jj = 0; jj < 4; ++jj) { const int e0 = jj * 32 + part * 8; const float* gp = lng + hd * 128 + e0; const float* bp = lnb + hd * 128 + e0;
            const f32x4 g0 = *(const f32x4*)gp, g1 = *(const f32x4*)(gp + 4), b0 = *(const f32x4*)bp, b1 = *(const f32x4*)(bp + 4);
            const float x[8] = {bflo(hv[jj].x), bfhi(hv[jj].x), bflo(hv[jj].y), bfhi(hv[jj].y), bflo(hv[jj].z), bfhi(hv[jj].z), bflo(hv[jj].w), bfhi(hv[jj].w)};
#pragma unroll
            for (int k = 0; k < 8; ++k) { const float gg = k < 4 ? g0[k & 3] : g1[k & 3], bb = k < 4 ? b0[k & 3] : b1[k & 3]; vT[(e0 + k) * 136 + t] = f2bf((x[k] - mu) * rstd * gg + bb); } }
    }
    u32x2 uu8[8], gt8[8];
#pragma unroll
    for (int nt = 0; nt < 8; ++nt) { const bf16_t* zq = Z + (tok0 + 16 * nt + fr) * ZP + hd * 128 + 16 * wid + 4 * fq;
        uu8[nt] = *(const u32x2*)(zq + C_GU); gt8[nt] = *(const u32x2*)(zq + C_GGATE); }
    bf16x8 bw[8][4];
#pragma unroll
    for (int nt = 0; nt < 8; ++nt)
#pragma unroll
        for (int ks = 0; ks <= (nt >> 1); ++ks) bw[nt][ks] = *(const bf16x8*)(Wm + hd * 16384 + (16 * nt + fr) * 128 + 32 * ks + 8 * fq);
    __syncthreads();
    bf16x8 af[4];
#pragma unroll
    for (int ks = 0; ks < 4; ++ks) af[ks] = *(const LAS bf16x8*)(vT + (16 * wid + fr) * 136 + 32 * ks + 8 * fq);
#pragma unroll
    for (int nt = 0; nt < 8; ++nt) {
        f32x4 acc = {0.f, 0.f, 0.f, 0.f};
#pragma unroll
        for (int ks = 0; ks <= (nt >> 1); ++ks) acc = MFMA16(af[ks], bw[nt][ks], acc);
        const int t = 16 * nt + fr; const int e = hd * 128 + 16 * wid + 4 * fq;
        bf16_t* zp = Z + (tok0 + t) * ZP + e;
        const u32x2 uu = uu8[nt], gt = gt8[nt]; const float bias = bs[hd * 128 + t];
        const float o0 = bflo(uu.x) * (acc[0] + bias) * siluf(bflo(gt.x)), o1 = bfhi(uu.x) * (acc[1] + bias) * siluf(bfhi(gt.x));
        const float o2 = bflo(uu.y) * (acc[2] + bias) * siluf(bflo(gt.y)), o3 = bfhi(uu.y) * (acc[3] + bias) * siluf(bfhi(gt.y));
        u32x2 w; w.x = pk2(o0, o1); w.y = pk2(o2, o3); if (ST) *(u32x2*)(zp + C_GU) = w; else *(LAS u32x2*)(lds + 139264 + lane * 16) = w;
    }
    __syncthreads();
}

typedef float f32x8v __attribute__((ext_vector_type(8)));
__device__ __forceinline__ f32x2_t pk_sub(f32x2_t a, f32x2_t b) { f32x2_t r; asm("v_pk_add_f32 %0, %1, %2 neg_lo:[0,1] neg_hi:[0,1]" : "=v"(r) : "v"(a), "v"(b)); return r; }
__device__ __forceinline__ float max3f(float a, float b, float c) { float r; asm("v_max3_f32 %0, %1, %2, %3" : "=v"(r) : "v"(a), "v"(b), "v"(c)); return r; }
__device__ __forceinline__ int crow(int i, int hh) { return (i & 3) + 8 * (i >> 2) + 4 * hh; }
template <bool ST> __device__ __forceinline__ void attn_qblock(LAS unsigned char* lds, bf16_t* Z, const bf16_t* VT, int b, int h, int qb, float lam, float oml, const float* subg, int tid, int wid, int lane) {
    asm volatile("" : "+v"(tid)); lane = tid & 63;
    const int c = wid >> 2, wq = wid & 3, l31 = lane & 31, hh = lane >> 5;
    const int q0 = qb * 128; const size_t tok0 = (size_t)b * SEQ;
    bf16x8 qf[4];
    { const bf16_t* qp = Z + (tok0 + q0 + 32 * wq + l31) * ZP + C_Q + h * 128 + c * 64 + 8 * hh;
#pragma unroll
      for (int ks = 0; ks < 4; ++ks) qf[ks] = *(const bf16x8*)(qp + 16 * ks); }
    f32x16 O[4];
#pragma unroll
    for (int d = 0; d < 4; ++d)
#pragma unroll
        for (int i = 0; i < 16; ++i) O[d][i] = 0.f;
    float mref = -1e30f, lsum = 0.f;
    const int nkt = 2 * qb + 2;
#define ATT_DMA(kt, sb) do { int t2 = tid; asm volatile("" : "+v"(t2)); const int krow = t2 >> 3, kch = (t2 & 7) ^ ((t2 >> 4) & 7); \
        const bf16_t* kg = Z + (tok0 + krow + (size_t)(kt) * 64) * ZP + C_K + h * 128 + kch * 8; \
        const bf16_t* vg = VT + ((size_t)(b * 1024 + h * 128 + krow)) * SEQ + kch * 8 + (kt) * 64; \
        LAS unsigned char* db = (sb) + wid * 1024; \
        __builtin_amdgcn_global_load_lds((const unsigned*)kg, (LAS unsigned*)(db), 16, 0, 0); \
        __builtin_amdgcn_global_load_lds((const unsigned*)(kg + 64), (LAS unsigned*)(db + 8192), 16, 0, 0); \
        __builtin_amdgcn_global_load_lds((const unsigned*)vg, (LAS unsigned*)(db + 16384), 16, 0, 0); \
        __builtin_amdgcn_global_load_lds((const unsigned*)(vg + (size_t)64 * SEQ), (LAS unsigned*)(db + 16384 + 8192), 16, 0, 0); } while (0)
    const int rsw = (l31 >> 1) & 7;
    const unsigned kro = (unsigned)(c * 8192 + l31 * 128), vro = (unsigned)(16384 + l31 * 128);
    unsigned cho[4];
#pragma unroll
    for (int j = 0; j < 4; ++j) { cho[j] = (unsigned)(((2 * j + hh) ^ rsw) * 16); }
    u32x4 pk[4];
    const int qrel = 32 * wq + l31;
#define ATT_MASKMAX(kt, A0, A1) \
        if ((kt) >= 2 * qb) { const int kb = 64 * ((kt) - 2 * qb); \
            _Pragma("unroll") for (int i = 0; i < 16; ++i) { const int kr = kb + crow(i, hh); if (kr > qrel) A0[i] = -1e30f; if (kr + 32 > qrel) A1[i] = -1e30f; } } \
        float mx; { float c0 = max3f(A0[0], A0[1], A0[2]), c1 = max3f(A0[8], A0[9], A0[10]), c2 = max3f(A1[0], A1[1], A1[2]), c3 = max3f(A1[8], A1[9], A1[10]); \
          c0 = max3f(c0, A0[3], A0[4]); c1 = max3f(c1, A0[11], A0[12]); c2 = max3f(c2, A1[3], A1[4]); c3 = max3f(c3, A1[11], A1[12]); \
          c0 = max3f(c0, A0[5], A0[6]); c1 = max3f(c1, A0[13], A0[14]); c2 = max3f(c2, A1[5], A1[6]); c3 = max3f(c3, A1[13], A1[14]); \
          c0 = max3f(c0, A0[7], c1); c2 = max3f(c2, A1[7], c3); c0 = max3f(c0, A0[15], A1[15]); c0 = max3f(c0, c2, c2); \
          const auto sw = __builtin_amdgcn_permlane32_swap(__float_as_uint(c0), __float_as_uint(c0), false, false); \
          const float e0 = __uint_as_float(sw[0]), e1 = __uint_as_float(sw[1]); mx = max3f(e0, e1, e1); } \
        float alpha = 1.f; const bool need = __builtin_amdgcn_ballot_w64(mx > mref + 8.f) != 0ull; \
        if (need) { const float mn = fmaxf(mref, mx); alpha = __builtin_amdgcn_exp2f(mref - mn); mref = mn; lsum *= alpha; }
#define ATT_EXP(A0, A1, PKN) \
        { const f32x2_t m2 = {mref, mref}; \
          _Pragma("unroll") for (int i = 0; i < 8; ++i) { f32x2_t t0 = {A0[2 * i], A0[2 * i + 1]}, t1 = {A1[2 * i], A1[2 * i + 1]}; t0 = pk_sub(t0, m2); t1 = pk_sub(t1, m2); \
              A0[2 * i] = t0.x; A0[2 * i + 1] = t0.y; A1[2 * i] = t1.x; A1[2 * i + 1] = t1.y; } } \
        _Pragma("unroll") for (int i = 0; i < 16; ++i) { A0[i] = __builtin_amdgcn_exp2f(A0[i]); A1[i] = __builtin_amdgcn_exp2f(A1[i]); } \
        { const f32x16 T = A0 + A1; \
          const f32x8v T8 = __builtin_shufflevector(T, T, 0, 1, 2, 3, 4, 5, 6, 7) + __builtin_shufflevector(T, T, 8, 9, 10, 11, 12, 13, 14, 15); \
          const f32x4 T4 = __builtin_shufflevector(T8, T8, 0, 1, 2, 3) + __builtin_shufflevector(T8, T8, 4, 5, 6, 7); \
          lsum += (T4[0] + T4[1]) + (T4[2] + T4[3]); } \
        _Pragma("unroll") for (int s = 0; s < 2; ++s) { const int o = 8 * s; \
            PKN[s].x = pk2(A0[o], A0[o + 1]); PKN[s].y = pk2(A0[o + 2], A0[o + 3]); PKN[s].z = pk2(A0[o + 4], A0[o + 5]); PKN[s].w = pk2(A0[o + 6], A0[o + 7]); \
            PKN[2 + s].x = pk2(A1[o], A1[o + 1]); PKN[2 + s].y = pk2(A1[o + 2], A1[o + 3]); PKN[2 + s].z = pk2(A1[o + 4], A1[o + 5]); PKN[2 + s].w = pk2(A1[o + 6], A1[o + 7]); }
#define VRD4(dst, sb, s) do { _Pragma("unroll") for (int d = 0; d < 4; ++d) dst[d] = *(const LAS bf16x8*)((sb) + vro + d * 4096 + cho[s]); } while (0)
#define KRD4(dst, sb, h2) do { _Pragma("unroll") for (int k2 = 0; k2 < 2; ++k2) { dst[2 * k2] = *(const LAS bf16x8*)((sb) + kro + cho[2 * (h2) + k2]); dst[2 * k2 + 1] = *(const LAS bf16x8*)((sb) + kro + 4096 + cho[2 * (h2) + k2]); } } while (0)
#define PV4(src, s, PK) do { const bf16x8 pf = __builtin_bit_cast(bf16x8, PK[s]); _Pragma("unroll") for (int d = 0; d < 4; ++d) O[d] = MFMA32(src[d], pf, O[d]); } while (0)
#define QK4A(src, B0, B1) do { B0 = MFMA32(src[0], qf[0], zero16); B1 = MFMA32(src[1], qf[0], zero16); B0 = MFMA32(src[2], qf[1], B0); B1 = MFMA32(src[3], qf[1], B1); } while (0)
#define QK4B(src, B0, B1) do { B0 = MFMA32(src[0], qf[2], B0); B1 = MFMA32(src[1], qf[2], B1); B0 = MFMA32(src[2], qf[3], B0); B1 = MFMA32(src[3], qf[3], B1); } while (0)
#define PIN(PKN) asm volatile("" : "+v"(PKN[0]), "+v"(PKN[1]), "+v"(PKN[2]), "+v"(PKN[3]), "+v"(lsum))
#define TAIL() do { if (need) { _Pragma("unroll") for (int d = 0; d < 4; ++d) O[d] = O[d] * alpha; } __syncthreads(); } while (0)
#define ATT_ITER(kt, A0, A1, B0, B1, PKP, PKN) do { \
        const LAS unsigned char* pst = lds + (((kt) + 3) & 3) * 32768; \
        const LAS unsigned char* nst = lds + (((kt) + 1) & 3) * 32768; \
        if ((kt) + 2 < nkt) ATT_DMA((kt) + 2, lds + (((kt) + 2) & 3) * 32768); \
        ATT_MASKMAX(kt, A0, A1) \
        __builtin_amdgcn_sched_barrier(0); \
        bf16x8 va[4], vb[4], ka[4], kb[4]; \
        VRD4(va, pst, 0); KRD4(ka, nst, 0); \
        PV4(va, 0, PKP); VRD4(vb, pst, 1); \
        QK4A(ka, B0, B1); KRD4(kb, nst, 1); \
        ATT_EXP(A0, A1, PKN) \
        PV4(vb, 1, PKP); VRD4(va, pst, 2); \
        QK4B(kb, B0, B1); \
        PV4(va, 2, PKP); VRD4(vb, pst, 3); \
        PV4(vb, 3, PKP); \
        PIN(PKN); \
        __builtin_amdgcn_sched_barrier(0); \
        TAIL(); } while (0)
    ATT_DMA(0, lds); ATT_DMA(1, lds + 32768);
    asm volatile("" :: "v"(qf[0]), "v"(qf[1]), "v"(qf[2]), "v"(qf[3]));
    __syncthreads();
    f32x16 zero16;
#pragma unroll
    for (int i = 0; i < 16; ++i) zero16[i] = 0.f;
    f32x16 S0, S1, N0, N1; u32x4 pkb[4];
    { bf16x8 ka[4], kb[4]; KRD4(ka, lds, 0); KRD4(kb, lds, 1); QK4A(ka, S0, S1); QK4B(kb, S0, S1); }
    asm volatile("s_nop 15\n\ts_nop 7" : "+v"(S0), "+v"(S1));
    {
        if (2 < nkt) ATT_DMA(2, lds + 2 * 32768);
        ATT_MASKMAX(0, S0, S1)
        const LAS unsigned char* nst = lds + 32768;
        __builtin_amdgcn_sched_barrier(0);
        bf16x8 ka[4], kb[4]; KRD4(ka, nst, 0); KRD4(kb, nst, 1);
        QK4A(ka, N0, N1);
        ATT_EXP(S0, S1, pk)
        QK4B(kb, N0, N1);
        PIN(pk);
        __builtin_amdgcn_sched_barrier(0);
        TAIL();
    }
#pragma unroll 1
    for (int kt = 1; kt + 1 < nkt; kt += 2) {
        ATT_ITER(kt, N0, N1, S0, S1, pk, pkb);
        ATT_ITER(kt + 1, S0, S1, N0, N1, pkb, pk);
    }
    {
        const int kt = nkt - 1;
        const LAS unsigned char* pst = lds + ((kt + 3) & 3) * 32768;
        ATT_MASKMAX(kt, N0, N1)
        __builtin_amdgcn_sched_barrier(0);
        bf16x8 va[4], vb[4];
        VRD4(va, pst, 0); VRD4(vb, pst, 1);
        PV4(va, 0, pk);
        ATT_EXP(N0, N1, pkb)
        PV4(vb, 1, pk); VRD4(va, pst, 2); VRD4(vb, pst, 3);
        PV4(va, 2, pk); PV4(vb, 3, pk);
        PIN(pkb);
        __builtin_amdgcn_sched_barrier(0);
        TAIL();
        const LAS unsigned char* lst = lds + (kt & 3) * 32768;
        VRD4(va, lst, 0); VRD4(vb, lst, 1); PV4(va, 0, pkb); PV4(vb, 1, pkb); VRD4(va, lst, 2); VRD4(vb, lst, 3); PV4(va, 2, pkb); PV4(vb, 3, pkb);
    }
    __syncthreads();
#undef VRD4
#undef KRD4
#undef PV4
#undef QK4A
#undef QK4B
#undef PIN
#undef TAIL
#undef ATT_ITER
#undef ATT_DMA
#undef ATT_MASKMAX
#undef ATT_EXP
    lsum += __shfl_xor(lsum, 32);
    const float inv = 1.f / lsum;
    LAS float* ox = (LAS float*)lds + wq * 4096;
    if (c == 1) {
#pragma unroll
        for (int d = 0; d < 4; ++d)
#pragma unroll
            for (int i = 0; i < 16; ++i) ox[(32 * d + crow(i, hh)) * 32 + l31] = O[d][i] * inv;
    }
    __syncthreads();
    if (c == 0) {
        float ss = 0.f;
#pragma unroll
        for (int d = 0; d < 4; ++d)
#pragma unroll
            for (int i = 0; i < 16; ++i) { const float o = O[d][i] * inv - lam * ox[(32 * d + crow(i, hh)) * 32 + l31]; O[d][i] = o; ss += o * o; }
        ss += __shfl_xor(ss, 32);
        const float rn = rsqrtf(ss * (1.f / 128.f) + 1e-6f) * oml;
        LAS bf16_t* TO = (LAS bf16_t*)(lds + 65536 + wq * 8704);
#pragma unroll
        for (int d = 0; d < 4; ++d)
#pragma unroll
            for (int g4 = 0; g4 < 4; ++g4) { const int dv0 = 32 * d + 8 * g4 + 4 * hh; const f32x4 sg = *(const f32x4*)(subg + dv0);
                u32x2 w; w.x = pk2(O[d][4 * g4] * rn * sg[0], O[d][4 * g4 + 1] * rn * sg[1]); w.y = pk2(O[d][4 * g4 + 2] * rn * sg[2], O[d][4 * g4 + 3] * rn * sg[3]);
                *(LAS u32x2*)(TO + l31 * 136 + dv0) = w; }
        asm volatile("s_waitcnt lgkmcnt(0)" ::: "memory");
#pragma unroll
        for (int rep = 0; rep < 8; ++rep) { const int p = lane + 64 * rep, row = p >> 4, c16 = p & 15;
            const u32x4 ov = *(const LAS u32x4*)(TO + row * 136 + c16 * 8);
            bf16_t* zp = Z + (tok0 + q0 + 32 * wq + row) * ZP + h * 128 + c16 * 8;
            const u32x4 gt = *(const u32x4*)(zp + C_AGATE);
            u32x4 w; w.x = pk2(bflo(ov.x) * siluf(bflo(gt.x)), bfhi(ov.x) * siluf(bfhi(gt.x))); w.y = pk2(bflo(ov.y) * siluf(bflo(gt.y)), bfhi(ov.y) * siluf(bfhi(gt.y)));
            w.z = pk2(bflo(ov.z) * siluf(bflo(gt.z)), bfhi(ov.z) * siluf(bfhi(gt.z))); w.w = pk2(bflo(ov.w) * siluf(bflo(gt.w)), bfhi(ov.w) * siluf(bfhi(gt.w)));
            if (ST) *(u32x4*)(zp + C_Q) = w; else *(LAS u32x4*)(lds + 139264 + lane * 16) = w; }
    }
    __syncthreads();
}

#define XB_TMO      128
#define XB_XCNT(j)  (256  + 64 * (j))
#define XB_XSUB(j)  (1280 + 64 * (j))
#define XB_XGEN(j)  (2304 + 64 * (j))
#define XB_TOP      3328
#define XB_TOPGEN   3392
#define XCD_BAR_WORDS 3456
#define XB_SPIN_CAP (1u << 22)
__device__ __forceinline__ unsigned xb_ld(unsigned* p)              { return __hip_atomic_load(p, __ATOMIC_RELAXED, __HIP_MEMORY_SCOPE_AGENT); }
__device__ __forceinline__ unsigned xb_add(unsigned* p, unsigned v) { return __hip_atomic_fetch_add(p, v, __ATOMIC_RELAXED, __HIP_MEMORY_SCOPE_AGENT); }
__device__ __forceinline__ unsigned xb_xcc_id() { return (unsigned)__builtin_amdgcn_s_getreg((3 << 11) | 20) & 0xFu; }
#define XB_SPIN(cond, bar) do { unsigned _sp = 0; while (cond) { __builtin_amdgcn_s_sleep(1); \
    if ((++_sp & 255u) == 0u) { if (xb_ld(&(bar)[XB_TMO])) break; if (_sp > XB_SPIN_CAP) { atomicAdd(&(bar)[XB_TMO], 1u); break; } } } } while (0)
struct XcdBarrier { unsigned* bar; unsigned x; volatile LAS unsigned* st; };
__device__ __forceinline__ XcdBarrier xcd_barrier_post(unsigned* bar, volatile LAS unsigned* st) {
    XcdBarrier b; b.bar = bar; b.x = xb_xcc_id(); b.st = st;
    if (threadIdx.x == 0) (void)xb_add(&bar[XB_XCNT(b.x)], 1u);
    return b;
}
__device__ __forceinline__ void xcd_barrier_complete(unsigned* bar, unsigned x, unsigned& nloc, unsigned& nx) {
    const unsigned G = gridDim.x * gridDim.y * gridDim.z;
    unsigned sum, cnt, mine, sp = 0u;
    for (;;) {
        sum = 0u; cnt = 0u; mine = 0u;
#pragma unroll
        for (unsigned j = 0; j < 16; ++j) { const unsigned c = xb_ld(&bar[XB_XCNT(j)]); sum += c; cnt += (c > 0u) ? 1u : 0u; mine = (j == x) ? c : mine; }
        if (sum == G) break;
        __builtin_amdgcn_s_sleep(1);
        if ((++sp & 255u) == 0u) { if (xb_ld(&bar[XB_TMO])) break; if (sp > XB_SPIN_CAP) { atomicAdd(&bar[XB_TMO], 1u); break; } }
    }
    nloc = mine > 0u ? mine : 1u; nx = cnt > 0u ? cnt : 1u;
}
__device__ __forceinline__ void xcd_barrier(const XcdBarrier& b) {
    asm volatile("s_waitcnt vmcnt(0)" ::: "memory");
    __syncthreads();
    if (threadIdx.x == 0) {
        unsigned* bar = b.bar;
        __builtin_amdgcn_s_waitcnt(0);
        unsigned nloc = b.st[0], nx = b.st[1];
        if (nloc == 0u) { xcd_barrier_complete(bar, b.x, nloc, nx); b.st[0] = nloc; b.st[1] = nx; }
        const unsigned old = xb_add(&bar[XB_XSUB(b.x)], 1u);
        const unsigned gen = old / nloc;
        if (old + 1u == (gen + 1u) * nloc) {
            __builtin_amdgcn_fence(__ATOMIC_RELEASE, "agent");
            asm volatile("s_waitcnt vmcnt(0)" ::: "memory");
            const unsigned og = xb_add(&bar[XB_TOP], 1u);
            const unsigned tg = og / nx;
            if (og + 1u == (tg + 1u) * nx) xb_add(&bar[XB_TOPGEN], 1u);
            else XB_SPIN(xb_ld(&bar[XB_TOPGEN]) == tg, bar);
            __builtin_amdgcn_fence(__ATOMIC_ACQUIRE, "agent");
            xb_add(&bar[XB_XGEN(b.x)], 1u);
            asm volatile("s_waitcnt vmcnt(0)" ::: "memory");
        } else {
            XB_SPIN(xb_ld(&bar[XB_XGEN(b.x)]) == gen, bar);
            __builtin_amdgcn_fence(__ATOMIC_ACQUIRE, "agent");
            asm volatile("s_waitcnt vmcnt(0)" ::: "memory");
        }
    }
    __syncthreads();
}
struct Params { const float* in[24]; float* out; unsigned char* ws; };

__global__ void __launch_bounds__(512, 2) mega_fwd(Params P) {
    extern __shared__ __attribute__((aligned(16))) unsigned char lds_raw[];
    LAS unsigned char* lds = (LAS unsigned char*)lds_raw;
    cg::grid_group grid = cg::this_grid();
    const int tid = threadIdx.x, lane = tid & 63, wid = __builtin_amdgcn_readfirstlane(tid >> 6);
    const int G = gridDim.x, bx = blockIdx.x;
    const int vcu = (G % 8 == 0) ? (bx % 8) * (G / 8) + bx / 8 : bx;
    const int gw = vcu * 8 + wid, NGW = G * 8;
    unsigned char* ws = P.ws;
    bf16_t* Z = (bf16_t*)(ws + OFF_Z); bf16_t* VT = (bf16_t*)(ws + OFF_VT); bf16_t* XB = (bf16_t*)(ws + OFF_XB);
    bf16_t* WinT = (bf16_t*)(ws + OFF_WIN); bf16_t* WoutT = (bf16_t*)(ws + OFF_WOUT); bf16_t* GluT = (bf16_t*)(ws + OFF_GLU);
    bf16_t* KC = (bf16_t*)(ws + OFF_KC); bf16_t* CCH = (bf16_t*)(ws + OFF_CCH); bf16_t* BCH = (bf16_t*)(ws + OFF_BCH); float* A16 = (float*)(ws + OFF_A16);
    float* part = (float*)(ws + OFF_PART); bf16_t* SGUW = (bf16_t*)(ws + OFF_SGUW); float* LAM = (float*)(ws + OFF_LAM);
    const float* x_in = P.in[0];
    unsigned* barw = (unsigned*)(ws + OFF_BAR);
    volatile LAS unsigned* bst = (volatile LAS unsigned*)(lds + LDS_BYTES - 16);
    if (tid == 0) { bst[0] = 0u; bst[1] = 0u; }
    __syncthreads();
    XcdBarrier xbar = xcd_barrier_post(barw, bst);
    if (P.ws == nullptr) grid.sync();
#define GSYNC() xcd_barrier(xbar)

#ifdef PROBE_P0X2
    for (int rep_ = 0; rep_ < 2; ++rep_) {
#else
    {
#endif
    conv_win(lds, P.in[2], P.in[1], WinT, gw, NGW, wid, lane);
    conv_plain(lds, P.in[11], 512, 512, GluT, gw, NGW, wid, lane);
    conv_plain(lds, P.in[11] + 512 * 512, 512, 512, GluT + 512 * 512, gw, NGW, wid, lane);
    __syncthreads();
#ifndef SKIP_S5P
    { S5In I{P.in[3], P.in[4], P.in[5], P.in[6], P.in[7], P.in[8], P.in[9], P.in[10]};
      for (int lg = vcu; lg < 64; lg += G) s5_params(lds, I, lg, KC, CCH, BCH, A16, tid); }
#endif
    for (int i = vcu * 512 + tid; i < 2 * 4 * 16384; i += G * 512) { const int t = (i >> 7) & 127, s = i & 127; SGUW[i] = f2bf(s <= t ? P.in[15][i] : 0.f); }
    if (bx == 0 && tid < 2) { const int l = tid; float d1 = 0.f, d2 = 0.f;
        for (int i = 0; i < 64; ++i) { d1 += P.in[17][l * 64 + i] * P.in[18][l * 64 + i]; d2 += P.in[19][l * 64 + i] * P.in[20][l * 64 + i]; }
        const float li = 0.8f - 0.6f * expf(-0.3f * (float)l); LAM[2 * l] = expf(d1) - expf(d2) + li; LAM[2 * l + 1] = 1.f - li; }
    for (int r0 = gw; r0 < T_TOK; r0 += 4 * NGW) {
        f32x4 v[4][4];
#pragma unroll
        for (int q = 0; q < 4; ++q) { const int r = r0 + q * NGW; if (r < T_TOK) { const f32x4* xr = (const f32x4*)(x_in + (size_t)r * DM) + lane;
#pragma unroll
            for (int j = 0; j < 4; ++j) v[q][j] = __builtin_nontemporal_load(xr + 64 * j); } }
#pragma unroll
        for (int q = 0; q < 4; ++q) { const int r = r0 + q * NGW; if (r < T_TOK) { float s = 0.f; u32x2* xo = (u32x2*)(XB + (size_t)r * DM) + lane;
#pragma unroll
            for (int j = 0; j < 4; ++j) { const f32x4 t = v[q][j]; s += (t[0] * t[0] + t[1] * t[1]) + (t[2] * t[2] + t[3] * t[3]); u32x2 w; w.x = pk2(t[0], t[1]); w.y = pk2(t[2], t[3]); xo[64 * j] = w; }
            s = wave_sum(s);
            if (lane < 16) part[(size_t)r * 16 + lane] = (lane == 0) ? s : 0.f; } }
    }
    __syncthreads();
    }
    GSYNC();

    for (int l = 0; l < 2; ++l) {
        conv_plain(lds, P.in[22] + (size_t)l * 2048 * 1024, 2048, 1024, WoutT, gw, NGW, wid, lane);
        __syncthreads();
        { pg8::Gemm g{XB, WinT, T_TOK, ZP, 1024, 1024, 1024}; pg8::StaticOrder S; S.init(T_TOK, ZP, G, bx); EpiIn E{Z, part};
          pg8::gemm_phase<EpiIn>(lds, g, S, E); }
#ifdef PROBE_P1X2
        { pg8::Gemm g{XB, WinT, T_TOK, ZP, 1024, 1024, 1024}; pg8::StaticOrder S; S.init(T_TOK, ZP, G, bx); EpiIn E{Z, part};
          pg8::gemm_phase<EpiIn>(lds, g, S, E); }
#endif
        { pg8::Gemm g{WinT + (size_t)ZP * 1024, XB, 1024, T_TOK, 1024, 1024, 1024}; pg8::StaticOrder S; S.init(1024, T_TOK, G, bx); EpiVT E{VT, part};
          pg8::gemm_phase<EpiVT>(lds, g, S, E); }
#ifdef PROBE_VTX2
        { pg8::Gemm g{WinT + (size_t)ZP * 1024, XB, 1024, T_TOK, 1024, 1024, 1024}; pg8::StaticOrder S; S.init(1024, T_TOK, G, bx); EpiVT E{VT, part};
          pg8::gemm_phase<EpiVT>(lds, g, S, E); }
#endif
        GSYNC();
#ifndef SKIP_S5
        for (int u = vcu; u < 256; u += G) { const int b = u >> 5, g = u & 31, lg = l * 32 + g;
            s5_unit<true>(lds, Z, KC + (size_t)lg * 4096, CCH + (size_t)lg * 32768, BCH + (size_t)lg * 32768, A16 + lg * 128, b, g, wid, lane); }
#endif
        {
          int nmine = 0; for (int u = vcu; u < 256; u += G) ++nmine;
          asm volatile("s_waitcnt vmcnt(0)" ::: "memory"); __syncthreads();
          if (tid == 0) { __builtin_amdgcn_fence(__ATOMIC_RELEASE, "agent"); asm volatile("s_waitcnt vmcnt(0)" ::: "memory");
              __hip_atomic_fetch_add(barw + 3600 + 64 * l, (unsigned)nmine, __ATOMIC_RELAXED, __HIP_MEMORY_SCOPE_AGENT); } }
#ifndef SKIP_SGU
        for (int u = vcu; u < 1024; u += G) { const int hd = u & 3, ch = (u >> 2) & 31, b = u >> 7;
            sgu_unit<true>(lds, Z, SGUW + (size_t)l * 65536, P.in[13] + l * 512, P.in[14] + l * 512, P.in[16] + l * 512, b, ch, hd, wid, lane); }
#endif
#ifdef PROBE_MIX2
        for (int u = vcu; u < 256; u += G) { const int b = u >> 5, g = u & 31, lg = l * 32 + g;
            s5_unit<false>(lds, Z, KC + (size_t)lg * 4096, CCH + (size_t)lg * 32768, BCH + (size_t)lg * 32768, A16 + lg * 128, b, g, wid, lane); }
        for (int u = vcu; u < 1024; u += G) { const int hd = u & 3, ch = (u >> 2) & 31, b = u >> 7;
            sgu_unit<false>(lds, Z, SGUW + (size_t)l * 65536, P.in[13] + l * 512, P.in[14] + l * 512, P.in[16] + l * 512, b, ch, hd, wid, lane); }
#endif
        { const float lam = LAM[2 * l], oml = LAM[2 * l + 1]; const float* subg = P.in[21] + l * 128;
#ifndef SKIP_ATT
          for (int u = vcu; u < 1024; u += G) { const int bh = u >> 4, pr = u & 15, b = bh >> 3, h = bh & 7;
              attn_qblock<true>(lds, Z, VT, b, h, 31 - pr, lam, oml, subg, tid, wid, lane);
              attn_qblock<true>(lds, Z, VT, b, h, pr, lam, oml, subg, tid, wid, lane); }
#endif
#ifdef PROBE_ATT2
          for (int u = vcu; u < 1024; u += G) { const int bh = u >> 4, pr = u & 15, b = bh >> 3, h = bh & 7;
              attn_qblock<false>(lds, Z, VT, b, h, 31 - pr, lam, oml, subg, tid, wid, lane);
              attn_qblock<false>(lds, Z, VT, b, h, pr, lam, oml, subg, tid, wid, lane); }
#endif
        }
        { asm volatile("s_waitcnt vmcnt(0)" ::: "memory"); __syncthreads();
          if (tid == 0) { unsigned sp = 0; while (__hip_atomic_load(barw + 3600 + 64 * l, __ATOMIC_RELAXED, __HIP_MEMORY_SCOPE_AGENT) < 256u) { __builtin_amdgcn_s_sleep(2); if (++sp > (1u << 24)) break; }
              __builtin_amdgcn_fence(__ATOMIC_ACQUIRE, "agent"); asm volatile("s_waitcnt vmcnt(0)" ::: "memory"); }
          __syncthreads(); }
        { pg8::Gemm g{Z + C_SIN, GluT + (size_t)l * 512 * 512, T_TOK, 512, 512, ZP, 512}; pg8::StaticOrder S; S.init(T_TOK, 512, G, bx); EpiGlu E{Z, P.in[12] + l * 512};
          pg8::gemm_phase<EpiGlu>(lds, g, S, E); }
        if (l == 0) { __syncthreads(); conv_win(lds, P.in[2] + (size_t)1024 * NIN, P.in[1] + 1024, WinT, gw, NGW, wid, lane); __syncthreads(); }
        GSYNC();
        if (l == 0) { pg8::Gemm g{Z, WoutT, T_TOK, DM, DMIX, ZP, DMIX}; pg8::StaticOrder S; S.init(T_TOK, DM, G, bx); EpiOut<false> E{x_in, P.out, XB, part};
          pg8::gemm_phase<EpiOut<false>>(lds, g, S, E); }
        else { pg8::Gemm g{Z, WoutT, T_TOK, DM, DMIX, ZP, DMIX}; pg8::StaticOrder S; S.init(T_TOK, DM, G, bx); EpiOut<true> E{P.out, P.out, XB, part};
          pg8::gemm_phase<EpiOut<true>>(lds, g, S, E); }
        GSYNC();
    }
#ifdef PROBE_SYNC20
    for (int i = 0; i < 20; ++i) GSYNC();
#endif
    for (int r0 = gw; r0 < T_TOK; r0 += 4 * NGW) {
        f32x4 v[4][4]; float ri[4];
#pragma unroll
        for (int q = 0; q < 4; ++q) { const int r = r0 + q * NGW; if (r < T_TOK) { ri[q] = row_rinv(part, r); const f32x4* xr = (const f32x4*)(P.out + (size_t)r * DM) + lane;
#pragma unroll
            for (int j = 0; j < 4; ++j) v[q][j] = xr[64 * j]; } }
        const f32x4* gg = (const f32x4*)P.in[23] + lane;
#pragma unroll
        for (int q = 0; q < 4; ++q) { const int r = r0 + q * NGW; if (r < T_TOK) { f32x4* xr = (f32x4*)(P.out + (size_t)r * DM) + lane;
#pragma unroll
            for (int j = 0; j < 4; ++j) xr[64 * j] = v[q][j] * ri[q] * gg[64 * j]; } }
    }
}

extern "C" void kernel_launch(void* const* d_in, const int* in_sizes, int n_in, void* d_out, int out_size, void* d_ws, size_t ws_size, hipStream_t stream) {
    static int grid_blocks = 0;
    if (!grid_blocks) {
        if (n_in != 24 || ws_size < WS_END) { fprintf(stderr, "kernel_launch: unexpected n_in %d / ws_size %zu (need %zu)\n", n_in, ws_size, (size_t)WS_END); grid_blocks = -1; return; }
        int dev = 0, cus = 0, per_cu = 0;
        hipGetDevice(&dev);
        hipDeviceGetAttribute(&cus, hipDeviceAttributeMultiprocessorCount, dev);
        hipFuncSetAttribute((const void*)mega_fwd, hipFuncAttributeMaxDynamicSharedMemorySize, LDS_BYTES);
        hipOccupancyMaxActiveBlocksPerMultiprocessor(&per_cu, (const void*)mega_fwd, 512, LDS_BYTES);
        if (per_cu < 1) { fprintf(stderr, "kernel_launch: occupancy query says %d blocks/CU\n", per_cu); per_cu = 1; }
        grid_blocks = cus * 1;
    }
    if (grid_blocks < 0) return;
    if (hipMemsetAsync((char*)d_ws + OFF_BAR, 0, 16384, stream) != hipSuccess) { fprintf(stderr, "kernel_launch: memset of the barrier words failed\n"); return; }
    Params p{};
    for (int i = 0; i < 24; ++i) p.in[i] = (const float*)d_in[i];
    p.out = (float*)d_out; p.ws = (unsigned char*)d_ws;
    void* args[] = {&p};
    hipError_t e = hipLaunchCooperativeKernel((const void*)mega_fwd, dim3(grid_blocks), dim3(512), args, LDS_BYTES, stream);
    if (e != hipSuccess) fprintf(stderr, "cooperative launch failed: %s (grid %d)\n", hipGetErrorString(e), grid_blocks);
}
```

```cpp
#include <hip/hip_runtime.h>
#include <hip/hip_cooperative_groups.h>
#include <cstdio>
#include <cstdint>
namespace cg = cooperative_groups;

#define LAS __attribute__((address_space(3)))
typedef unsigned short bf16_t;
typedef short bf16x8 __attribute__((ext_vector_type(8)));
typedef float f32x4 __attribute__((ext_vector_type(4)));
typedef float f32x16 __attribute__((ext_vector_type(16)));
typedef unsigned u32x4 __attribute__((ext_vector_type(4)));
typedef unsigned u32x2 __attribute__((ext_vector_type(2)));
typedef float f32x2_t __attribute__((ext_vector_type(2)));
typedef __bf16 bf16x2_t __attribute__((ext_vector_type(2)));

__device__ __forceinline__ unsigned pk2(float lo, float hi) { f32x2_t v = {lo, hi}; bf16x2_t b = __builtin_convertvector(v, bf16x2_t); return __builtin_bit_cast(unsigned, b); }
__device__ __forceinline__ float bflo(unsigned u) { return __uint_as_float(u << 16); }
__device__ __forceinline__ float bfhi(unsigned u) { return __uint_as_float(u & 0xffff0000u); }
__device__ __forceinline__ bf16_t f2bf(float f) { return (bf16_t)(pk2(f, 0.f) & 0xffffu); }
__device__ __forceinline__ float siluf(float x) { return x / (1.f + __expf(-x)); }
__device__ __forceinline__ float sigmf(float x) { return 1.f / (1.f + __expf(-x)); }
__device__ __forceinline__ float wave_sum(float v) {
#pragma unroll
    for (int o = 1; o < 64; o <<= 1) v += __shfl_xor(v, o);
    return v;
}
#define MFMA16(a, b, c) __builtin_amdgcn_mfma_f32_16x16x32_bf16((a), (b), (c), 0, 0, 0)
#define MFMA32(a, b, c) __builtin_amdgcn_mfma_f32_32x32x16_bf16((a), (b), (c), 0, 0, 0)

constexpr int T_TOK = 32768, DM = 1024, SEQ = 4096, NBATCH = 8, ZP = 5632, NIN = 6656, DMIX = 2048;
constexpr int C_SGATE = 0, C_GU = 512, C_Q = 1024, C_SIN = 2048, C_GV = 2560, C_GGATE = 3072, C_K = 3584, C_AGATE = 4608;
constexpr float C2 = 0.125f * 1.4426950408889634f;
constexpr size_t OFF_Z = 0, SZ_Z = (size_t)T_TOK * ZP * 2;
constexpr size_t OFF_VT = OFF_Z + SZ_Z, SZ_VT = (size_t)T_TOK * 1024 * 2;
constexpr size_t OFF_XB = OFF_VT + SZ_VT, SZ_XB = (size_t)T_TOK * 1024 * 2;
constexpr size_t OFF_WIN = OFF_XB + SZ_XB, SZ_WIN = (size_t)NIN * 1024 * 2;
constexpr size_t OFF_WOUT = OFF_WIN + SZ_WIN, SZ_WOUT = (size_t)1024 * 2048 * 2;
constexpr size_t OFF_GLU = OFF_WOUT + SZ_WOUT, SZ_GLU = (size_t)2 * 512 * 512 * 2;
constexpr size_t OFF_KC = OFF_GLU + SZ_GLU, SZ_KC = (size_t)64 * 4096 * 2;
constexpr size_t OFF_CCH = OFF_KC + SZ_KC, SZ_CCH = (size_t)64 * 32768 * 2;
constexpr size_t OFF_BCH = OFF_CCH + SZ_CCH, SZ_BCH = (size_t)64 * 32768 * 2;
constexpr size_t OFF_A16 = OFF_BCH + SZ_BCH, SZ_A16 = (size_t)64 * 64 * 8;
constexpr size_t OFF_PART = OFF_A16 + SZ_A16, SZ_PART = (size_t)T_TOK * 16 * 4;
constexpr size_t OFF_SGUW = OFF_PART + SZ_PART, SZ_SGUW = (size_t)2 * 4 * 128 * 128 * 2;
constexpr size_t OFF_LAM = OFF_SGUW + SZ_SGUW, OFF_BAR = OFF_LAM + 256, WS_END = OFF_BAR + 16384;
constexpr int LDS_BYTES = 147456;

namespace pg8 {
constexpr int BM = 256, BK = 64, HALF = 128, HTB = HALF * BK * 2, STAGE_BYTES = 8 * HTB, NXCD = 8, WGM = 8;
__host__ __device__ __forceinline__ int lds_byte(int r, int c) { const int st = (r >> 4) * 2 + (c >> 5), rr = r & 15, cc = c & 31, ob = rr * 64 + cc * 2; return st * 1024 + (ob ^ (((ob >> 9) & 1) << 5)); }
__host__ __device__ __forceinline__ void stage_rc(int b, int& R, int& C) { const int st = b / 1024, sb = b % 1024, swz = sb ^ (((sb >> 9) & 1) << 5); R = (st >> 1) * 16 + swz / 64; C = (st & 1) * 32 + (swz % 64) / 2; }
__host__ __device__ __forceinline__ int perm32(int rho) { const int n = rho >> 4, i = rho & 15; return 8 * (i >> 2) + 4 * n + (i & 3); }
__host__ __device__ __forceinline__ int permV(int rho) { const int n = rho >> 4, i = rho & 15, q = i >> 2, j = i & 3; return 16 * (q >> 1) + 8 * n + 4 * (q & 1) + j; }
struct Unit { int pm, pn; };
struct Gemm { const bf16_t* A; const bf16_t* Bt; int M, N, K, lda, ldb; };
struct StaticOrder {
    int nM, nN, nwg, G, c;
    __device__ void init(int M, int N, int G_, int c_) { nM = M / BM; nN = N / BM; nwg = nM * nN; G = G_; c = c_; }
    __device__ bool next(int i, Unit& u) const {
        const long L = (long)i * G + c; if (L >= nwg) return false;
        int wgid = (int)L; { const int q = nwg / NXCD, r = nwg % NXCD, xcd = wgid % NXCD, off = wgid / NXCD; wgid = (xcd < r ? xcd * (q + 1) : r * (q + 1) + (xcd - r) * q) + off; }
        const int nig = WGM * nN, gid = wgid / nig, fm = gid * WGM, gsz = (nM - fm) < WGM ? (nM - fm) : WGM;
        u.pm = fm + ((wgid % nig) % gsz); u.pn = (wgid % nig) / gsz; return true;
    }
};
template <class Epi>
__device__ __forceinline__ void gemm_phase(LAS unsigned char* lds, const Gemm g, const StaticOrder& S, const Epi& E) {
    int tid = threadIdx.x; asm volatile("" : "+v"(tid));
    const int wid = __builtin_amdgcn_readfirstlane(tid >> 6), lane = tid & 63, wr = wid >> 2, wc = wid & 3, fr = lane & 15, fq = lane >> 4;
    const int K = g.K, nt = K / BK;
    unsigned voffA[2], voffB[2];
#pragma unroll
    for (int i = 0; i < 2; ++i) { int R, C; stage_rc(tid * 16 + i * 8192, R, C);
        const int Rb = (Epi::PERM == 1) ? ((R & ~31) + perm32(R & 31)) : (Epi::PERM == 2) ? ((R & ~31) + permV(R & 31)) : R;
        voffA[i] = (unsigned)(R * g.lda + C) * 2u; voffB[i] = (unsigned)(Rb * g.ldb + C) * 2u; }
    const size_t kstep = (size_t)(BK * 2);
    const size_t hstepA = (size_t)HALF * g.lda * 2, hstepB = (size_t)HALF * g.ldb * 2;
    const size_t tstepA = 2 * hstepA, tstepB = 2 * hstepB;
    const unsigned ldsw = (unsigned)wid * 1024u;
    const int aoff = lds_byte(wr * 64 + fr, fq * 8), boff = lds_byte(wc * 32 + fr, fq * 8);
#define PG8_SA(b, h) (((b) * 2 + (h)) * HTB)
#define PG8_SB(b, h) ((4 + (b) * 2 + (h)) * HTB)
#define PG8_STAGE(bufoff, gbase, voff) do { _Pragma("unroll") for (int _i = 0; _i < 2; ++_i) \
        __builtin_amdgcn_global_load_lds((const unsigned*)((const char*)(gbase) + (voff)[_i]), (LAS unsigned*)(lds + (bufoff) + ldsw + _i * 8192), 16, 0, 0); } while (0)
#define PG8_LDA(dst, b, h) do { _Pragma("unroll") for (int m = 0; m < 4; ++m) _Pragma("unroll") for (int k = 0; k < 2; ++k) dst[m][k] = *(const LAS bf16x8*)(lds + PG8_SA(b, h) + aoff + m * 2048 + k * 1024); } while (0)
#define PG8_LDB(dst, b, h) do { _Pragma("unroll") for (int n = 0; n < 2; ++n) _Pragma("unroll") for (int k = 0; k < 2; ++k) dst[n][k] = *(const LAS bf16x8*)(lds + PG8_SB(b, h) + boff + n * 2048 + k * 1024); } while (0)
#define PG8_MMA(ai, bj, At, Bt) do { __builtin_amdgcn_s_setprio(1); _Pragma("unroll") for (int m = 0; m < 4; ++m) _Pragma("unroll") for (int n = 0; n < 2; ++n) _Pragma("unroll") for (int k = 0; k < 2; ++k) \
        acc[ai][bj][m][n] = __builtin_amdgcn_mfma_f32_16x16x32_bf16(Bt[n][k], At[m][k], acc[ai][bj][m][n], 0, 0, 0); __builtin_amdgcn_s_setprio(0); } while (0)
#define PG8_WAIT_V(n) asm volatile("s_waitcnt vmcnt(" #n ")" ::: "memory")
#define PG8_WAIT_L(n) asm volatile("s_waitcnt lgkmcnt(" #n ")" ::: "memory")
#define PG8_BAR __builtin_amdgcn_s_barrier()
#define PG8_SCHED __builtin_amdgcn_sched_barrier(0)
    Unit cur, nxt; int ui = 0;
    if (!S.next(0, cur)) return;
    f32x4 acc[2][2][4][2];
#pragma unroll
    for (int a = 0; a < 2; ++a)
#pragma unroll
        for (int b = 0; b < 2; ++b)
#pragma unroll
            for (int m = 0; m < 4; ++m)
#pragma unroll
                for (int n = 0; n < 2; ++n) acc[a][b][m][n] = (f32x4){0.f, 0.f, 0.f, 0.f};
    bf16x8 At[4][2], B0[2][2], B1[2][2];
    const char* cA = (const char*)g.A + (size_t)cur.pm * tstepA; const char* cB = (const char*)g.Bt + (size_t)cur.pn * tstepB;
    PG8_STAGE(PG8_SB(0, 0), cB, voffB); PG8_STAGE(PG8_SB(0, 1), cB + hstepB, voffB); PG8_STAGE(PG8_SA(0, 0), cA, voffA); PG8_STAGE(PG8_SA(0, 1), cA + hstepA, voffA);
    if (wr == 1) PG8_BAR;
    PG8_WAIT_V(2); PG8_BAR;
    PG8_STAGE(PG8_SB(1, 0), cB + kstep, voffB); PG8_STAGE(PG8_SA(1, 0), cA + kstep, voffA); PG8_STAGE(PG8_SB(1, 1), cB + hstepB + kstep, voffB);
    PG8_WAIT_V(6); PG8_BAR;
    for (;;) {
        const bool has_next = S.next(ui + 1, nxt);
        const char* nA = has_next ? (const char*)g.A + (size_t)nxt.pm * tstepA : cA; const char* nB = has_next ? (const char*)g.Bt + (size_t)nxt.pn * tstepB : cB;
        for (int t = 0; t < nt; t += 2) {
            const bool last = (t == nt - 2);
            const char* a1 = cA + (size_t)(t + 1) * kstep;
            const char* a2 = last ? nA : cA + (size_t)(t + 2) * kstep; const char* b2 = last ? nB : cB + (size_t)(t + 2) * kstep;
            const char* a3 = a2 + kstep; const char* b3 = b2 + kstep;
            PG8_LDB(B0, 0, 0); PG8_LDB(B1, 0, 1); PG8_SCHED; PG8_LDA(At, 0, 0); PG8_STAGE(PG8_SA(1, 1), a1 + hstepA, voffA);
            PG8_WAIT_V(8); PG8_WAIT_L(0); PG8_BAR; PG8_MMA(0, 0, At, B0); PG8_MMA(0, 1, At, B1); PG8_BAR; PG8_SCHED;
            PG8_LDA(At, 0, 1); PG8_STAGE(PG8_SB(0, 0), b2, voffB); PG8_STAGE(PG8_SB(0, 1), b2 + hstepB, voffB); PG8_STAGE(PG8_SA(0, 0), a2, voffA);
            PG8_WAIT_V(8); PG8_WAIT_L(0); PG8_BAR; PG8_MMA(1, 0, At, B0); PG8_MMA(1, 1, At, B1); PG8_BAR; PG8_SCHED;
            PG8_LDB(B0, 1, 0); PG8_LDB(B1, 1, 1); PG8_SCHED; PG8_LDA(At, 1, 0); PG8_STAGE(PG8_SA(0, 1), a2 + hstepA, voffA);
            PG8_WAIT_V(8); PG8_WAIT_L(0); PG8_BAR; PG8_MMA(0, 0, At, B0); PG8_MMA(0, 1, At, B1); PG8_BAR; PG8_SCHED;
            PG8_LDA(At, 1, 1); PG8_STAGE(PG8_SB(1, 0), b3, voffB); PG8_STAGE(PG8_SB(1, 1), b3 + hstepB, voffB); PG8_STAGE(PG8_SA(1, 0), a3, voffA);
            PG8_WAIT_V(8); PG8_WAIT_L(0); PG8_BAR; PG8_MMA(1, 0, At, B0); PG8_MMA(1, 1, At, B1); PG8_BAR; PG8_SCHED;
        }
        if (wr == 0) PG8_BAR;
        E(acc, cur, wr, wc, fr, fq);
        if (!has_next) break;
#pragma unroll
        for (int a = 0; a < 2; ++a)
#pragma unroll
            for (int b = 0; b < 2; ++b)
#pragma unroll
                for (int m = 0; m < 4; ++m)
#pragma unroll
                    for (int n = 0; n < 2; ++n) acc[a][b][m][n] = (f32x4){0.f, 0.f, 0.f, 0.f};
        cur = nxt; cA = nA; cB = nB; ++ui;
        if (wr == 1) PG8_BAR;
    }
    PG8_WAIT_V(0);
    PG8_BAR;
#undef PG8_SA
#undef PG8_SB
#undef PG8_STAGE
#undef PG8_LDA
#undef PG8_LDB
#undef PG8_MMA
#undef PG8_WAIT_V
#undef PG8_WAIT_L
#undef PG8_BAR
#undef PG8_SCHED
}
}

typedef f32x4 AccT[2][2][4][2];
__device__ __forceinline__ float row_rinv(const float* part, int row) {
    const f32x4* p = (const f32x4*)(part + (size_t)row * 16);
    const f32x4 a = p[0], b = p[1], c = p[2], d = p[3];
    const float s = ((a[0] + a[1]) + (a[2] + a[3])) + ((b[0] + b[1]) + (b[2] + b[3])) + ((c[0] + c[1]) + (c[2] + c[3])) + ((d[0] + d[1]) + (d[2] + d[3]));
    return rsqrtf(s * (1.f / 1024.f) + 1e-6f);
}
struct EpiIn {
    static constexpr int PERM = 1;
    bf16_t* Z; const float* part;
    __device__ __forceinline__ void operator()(const AccT& acc, const pg8::Unit& u, int wr, int wc, int fr, int fq) const {
        const float qs = (u.pn >= 4 && u.pn < 8) ? C2 : 1.f;
#pragma unroll
        for (int ai = 0; ai < 2; ++ai)
#pragma unroll
            for (int m = 0; m < 4; ++m) {
                const int row = u.pm * 256 + ai * 128 + wr * 64 + m * 16 + fr;
                const float sc = row_rinv(part, row) * qs;
                bf16_t* rp = Z + (size_t)row * ZP + u.pn * 256 + wc * 32 + 8 * fq;
#pragma unroll
                for (int bj = 0; bj < 2; ++bj) { const f32x4 v0 = acc[ai][bj][m][0] * sc, v1 = acc[ai][bj][m][1] * sc;
                    u32x4 w; w.x = pk2(v0[0], v0[1]); w.y = pk2(v0[2], v0[3]); w.z = pk2(v1[0], v1[1]); w.w = pk2(v1[2], v1[3]);
                    __builtin_nontemporal_store(w, (u32x4*)(rp + bj * 128)); }
            }
    }
};
struct EpiVT {
    static constexpr int PERM = 2;
    bf16_t* VT; const float* part;
    __device__ __forceinline__ void operator()(const AccT& acc, const pg8::Unit& u, int wr, int wc, int fr, int fq) const {
#pragma unroll
        for (int bj = 0; bj < 2; ++bj) {
            const int g32 = u.pn * 256 + bj * 128 + wc * 32;
            const int t0 = g32 + 16 * (fq >> 1) + 4 * (fq & 1);
            f32x4 r0, r1;
            r0[0] = row_rinv(part, t0); r0[1] = row_rinv(part, t0 + 1); asm volatile("" : "+v"(r0[0]), "+v"(r0[1]));
            r0[2] = row_rinv(part, t0 + 2); r0[3] = row_rinv(part, t0 + 3); asm volatile("" : "+v"(r0[2]), "+v"(r0[3]));
            r1[0] = row_rinv(part, t0 + 8); r1[1] = row_rinv(part, t0 + 9); asm volatile("" : "+v"(r1[0]), "+v"(r1[1]));
            r1[2] = row_rinv(part, t0 + 10); r1[3] = row_rinv(part, t0 + 11); asm volatile("" : "+v"(r1[2]), "+v"(r1[3]));
            const int b = g32 >> 12, tp = (g32 & 4095) + 16 * (fq >> 1) + 8 * (fq & 1);
#pragma unroll
            for (int ai = 0; ai < 2; ++ai)
#pragma unroll
                for (int m = 0; m < 4; ++m) { const int ch = u.pm * 256 + ai * 128 + wr * 64 + m * 16 + fr;
                    const f32x4 v0 = acc[ai][bj][m][0] * r0, v1 = acc[ai][bj][m][1] * r1;
                    u32x4 w; w.x = pk2(v0[0], v0[1]); w.y = pk2(v0[2], v0[3]); w.z = pk2(v1[0], v1[1]); w.w = pk2(v1[2], v1[3]);
                    *(u32x4*)(VT + ((size_t)(b * 1024 + ch)) * SEQ + tp) = w; }
        }
    }
};
struct EpiGlu {
    static constexpr int PERM = 1;
    bf16_t* Z; const float* gb;
    __device__ __forceinline__ void operator()(const AccT& acc, const pg8::Unit& u, int wr, int wc, int fr, int fq) const {
#pragma unroll
        for (int ai = 0; ai < 2; ++ai)
#pragma unroll
            for (int m = 0; m < 4; ++m) {
                const int row = u.pm * 256 + ai * 128 + wr * 64 + m * 16 + fr;
#pragma unroll
                for (int bj = 0; bj < 2; ++bj) { const int col = u.pn * 256 + bj * 128 + wc * 32 + 8 * fq;
                    bf16_t* zp = Z + (size_t)row * ZP + col;
                    const u32x4 yp = *(const u32x4*)(zp + C_SIN), gt = *(const u32x4*)(zp + C_SGATE);
                    const f32x4 a0 = acc[ai][bj][m][0] + *(const f32x4*)(gb + col), a1 = acc[ai][bj][m][1] + *(const f32x4*)(gb + col + 4);
                    u32x4 w;
                    w.x = pk2(bflo(yp.x) * sigmf(a0[0]) * siluf(bflo(gt.x)), bfhi(yp.x) * sigmf(a0[1]) * siluf(bfhi(gt.x)));
                    w.y = pk2(bflo(yp.y) * sigmf(a0[2]) * siluf(bflo(gt.y)), bfhi(yp.y) * sigmf(a0[3]) * siluf(bfhi(gt.y)));
                    w.z = pk2(bflo(yp.z) * sigmf(a1[0]) * siluf(bflo(gt.z)), bfhi(yp.z) * sigmf(a1[1]) * siluf(bfhi(gt.z)));
                    w.w = pk2(bflo(yp.w) * sigmf(a1[2]) * siluf(bflo(gt.w)), bfhi(yp.w) * sigmf(a1[3]) * siluf(bfhi(gt.w)));
                    *(u32x4*)(zp + C_SGATE) = w; }
            }
    }
};
template <bool LAST> struct EpiOut {
    static constexpr int PERM = 1;
    const float* xold; float* out; bf16_t* XB; float* part;
    __device__ __forceinline__ void operator()(const AccT& acc, const pg8::Unit& u, int wr, int wc, int fr, int fq) const {
#pragma unroll
        for (int ai = 0; ai < 2; ++ai)
#pragma unroll
            for (int m = 0; m < 4; ++m) {
                const int row = u.pm * 256 + ai * 128 + wr * 64 + m * 16 + fr; float ss = 0.f;
#pragma unroll
                for (int bj = 0; bj < 2; ++bj)
#pragma unroll
                    for (int n = 0; n < 2; ++n) { const size_t o = (size_t)row * DM + u.pn * 256 + bj * 128 + wc * 32 + 8 * fq + 4 * n;
                        const f32x4 xn = *(const f32x4*)(xold + o) + acc[ai][bj][m][n];
                        *(f32x4*)(out + o) = xn; if (!LAST) { u32x2 w; w.x = pk2(xn[0], xn[1]); w.y = pk2(xn[2], xn[3]); *(u32x2*)(XB + o) = w; }
                        ss += (xn[0] * xn[0] + xn[1] * xn[1]) + (xn[2] * xn[2] + xn[3] * xn[3]); }
                ss += __shfl_xor(ss, 16); ss += __shfl_xor(ss, 32);
                if (fq == 0) part[(size_t)row * 16 + u.pn * 4 + wc] = ss;
            }
    }
};

__device__ __forceinline__ int remap_col(int n) {
    if (n < 512) return 512 + n;
    if (n < 1024) return 1024 + (n - 512);
    if (n < 2048) return 2560 + (n - 1024);
    if (n < 2560) return n - 2048;
    if (n < 3072) return 1536 + (n - 2560);
    if (n < 3584) return 2048 + (n - 3072);
    if (n < 4608) return n;
    if (n < 5632) return 5632 + (n - 4608);
    return 4608 + (n - 5632);
}
__device__ __forceinline__ void transpose_item(const float* W, int K, int N, int srcn0, const float* kscale, bf16_t* WT, int dstrow0, LAS float* scr, int k0, int lane) {
    asm volatile("" : "+v"(lane));
#pragma unroll 8
    for (int i = 0; i < 32; ++i) { const int kk = 2 * i + (lane >> 5); float v = W[(size_t)(k0 + kk) * N + srcn0 + (lane & 31)]; if (kscale) v *= kscale[k0 + kk]; scr[kk * 33 + (lane & 31)] = v; }
    asm volatile("s_waitcnt lgkmcnt(0)" ::: "memory");
    const int c = lane & 7;
#pragma unroll
    for (int j = 0; j < 4; ++j) { const int n = (lane >> 3) + 8 * j; const LAS float* s = scr + (8 * c) * 33 + n;
        u32x4 o; o.x = pk2(s[0 * 33], s[1 * 33]); o.y = pk2(s[2 * 33], s[3 * 33]); o.z = pk2(s[4 * 33], s[5 * 33]); o.w = pk2(s[6 * 33], s[7 * 33]);
        *(u32x4*)(WT + (size_t)(dstrow0 + n) * K + k0 + 8 * c) = o; }
    asm volatile("s_waitcnt lgkmcnt(0)" ::: "memory");
}
__device__ __forceinline__ void conv_win(LAS unsigned char* lds, const float* w_in_l, const float* g_l, bf16_t* WinT, int gw, int NGW, int wid, int lane) {
    LAS float* scr = (LAS float*)(lds + wid * 8448);
    for (int it = gw; it < 16 * 208; it += NGW) { const int kb = it / 208, nb = it % 208; transpose_item(w_in_l, 1024, NIN, remap_col(32 * nb), g_l, WinT, 32 * nb, scr, 64 * kb, lane); }
}
__device__ __forceinline__ void conv_plain(LAS unsigned char* lds, const float* W, int K, int N, bf16_t* WT, int gw, int NGW, int wid, int lane) {
    LAS float* scr = (LAS float*)(lds + wid * 8448);
    const int nbn = N / 32, nit = (K / 64) * nbn;
    for (int it = gw; it < nit; it += NGW) { const int kb = it / nbn, nb = it % nbn; transpose_item(W, K, N, 32 * nb, nullptr, WT, 32 * nb, scr, 64 * kb, lane); }
}
struct S5In { const float *a_re, *a_im, *lstep, *b_re, *b_im, *c_re, *c_im, *d; };
__device__ __forceinline__ void s5_params(LAS unsigned char* lds, const S5In& I, int lg, bf16_t* KcO, bf16_t* CchO, bf16_t* BchO, float* A16O, int tid) {
    asm volatile("" : "+v"(tid));
    typedef float f2 __attribute__((ext_vector_type(2)));
    LAS f2* pw = (LAS f2*)lds;
    LAS f2* Bb = (LAS f2*)(lds + 8704);
    LAS f2* Cc = (LAS f2*)(lds + 16896);
    if (tid < 64) {
        const int p = tid; const float lr = I.a_re[lg * 64 + p], li = I.a_im[lg * 64 + p], step = expf(I.lstep[lg]);
        const float mag = expf(step * lr), ang = step * li; float sn, cs; sincosf(ang, &sn, &cs);
        const float abr = mag * cs, abi = mag * sn;
        f2 w = {1.f, 0.f}; pw[p] = w;
#pragma unroll 1
        for (int t = 1; t <= 16; ++t) { const f2 n = {w.x * abr - w.y * abi, w.x * abi + w.y * abr}; w = n; pw[t * 64 + p] = w; }
        A16O[(lg * 64 + p) * 2] = w.x; A16O[(lg * 64 + p) * 2 + 1] = w.y;
        const float den = lr * lr + li * li, nr = abr - 1.f, ni = abi;
        const float cor = (nr * lr + ni * li) / den, coi = (ni * lr - nr * li) / den;
#pragma unroll 1
        for (int h = 0; h < 16; ++h) { const float br = I.b_re[(lg * 64 + p) * 16 + h], bi = I.b_im[(lg * 64 + p) * 16 + h]; const f2 v = {cor * br - coi * bi, cor * bi + coi * br}; Bb[p * 16 + h] = v; }
    }
#pragma unroll 1
    for (int i = tid; i < 1024; i += 512) { const f2 v = {I.c_re[lg * 1024 + i], I.c_im[lg * 1024 + i]}; Cc[i] = v; }
    __syncthreads();
#pragma unroll 1
    for (int e = tid; e < 4096; e += 512) { const int t = e >> 8, h = (e >> 4) & 15, h2 = e & 15; float a = 0.f;
#pragma unroll 4
        for (int p = 0; p < 64; ++p) { const f2 w = pw[t * 64 + p], cc = Cc[h * 64 + p], bb = Bb[p * 16 + h2]; const float tr = cc.x * w.x - cc.y * w.y, ti = cc.x * w.y + cc.y * w.x; a += tr * bb.x - ti * bb.y; }
        if (t == 0 && h == h2) a += I.d[(lg >> 5) * 512 + (lg & 31) * 16 + h];
        KcO[(size_t)lg * 4096 + e] = f2bf(a); }
#pragma unroll 2
    for (int e = tid; e < 32768; e += 512) { const int r = e >> 7, p2 = e & 127, t = r >> 4, h = r & 15, p = p2 & 63;
        const f2 w = pw[(t + 1) * 64 + p], cc = Cc[h * 64 + p]; const float Wr = cc.x * w.x - cc.y * w.y, Wi = cc.x * w.y + cc.y * w.x;
        CchO[(size_t)lg * 32768 + e] = f2bf(p2 < 64 ? Wr : -Wi); }
#pragma unroll 2
    for (int e = tid; e < 32768; e += 512) { const int p2 = e >> 8, k = e & 255, j = k >> 4, h2 = k & 15, p = p2 & 63;
        const f2 w = pw[(15 - j) * 64 + p], bb = Bb[p * 16 + h2]; const float Gr = w.x * bb.x - w.y * bb.y, Gi = w.x * bb.y + w.y * bb.x;
        BchO[(size_t)lg * 32768 + e] = f2bf(p2 < 64 ? Gr : Gi); }
    __syncthreads();
}

__device__ __forceinline__ float gelu_exact(float y) { return 0.5f * y * (1.f + erff(y * 0.70710678118654752f)); }
template <bool ST> __device__ __forceinline__ void s5_unit(LAS unsigned char* lds, bf16_t* Z, const bf16_t* Kc, const bf16_t* Cch, const bf16_t* Bch, const float* A16, int b, int g, int wid, int lane) {
    asm volatile("" : "+v"(lane));
    const int fr = lane & 15, fq = lane >> 4;
    LAS float* S = (LAS float*)lds;
    const size_t tokb = (size_t)b * SEQ;
    bf16x8 uf[2][8];
#pragma unroll
    for (int n2 = 0; n2 < 2; ++n2)
#pragma unroll
        for (int ks = 0; ks < 8; ++ks) { const int c = 16 * (2 * wid + n2) + fr;
            uf[n2][ks] = *(const bf16x8*)(Z + (tokb + 16 * c + 2 * ks + (fq >> 1)) * ZP + C_SIN + 16 * g + 8 * (fq & 1)); }
#pragma unroll 2
    for (int mt = 0; mt < 8; ++mt) {
        f32x4 a0 = {0.f, 0.f, 0.f, 0.f}, a1 = {0.f, 0.f, 0.f, 0.f};
#pragma unroll
        for (int ks = 0; ks < 8; ++ks) { const bf16x8 a = *(const bf16x8*)(Bch + (16 * mt + fr) * 256 + 32 * ks + 8 * fq); a0 = MFMA16(a, uf[0][ks], a0); a1 = MFMA16(a, uf[1][ks], a1); }
        *(LAS f32x4*)(S + (16 * (2 * wid) + fr) * 128 + 16 * mt + 4 * fq) = a0;
        *(LAS f32x4*)(S + (16 * (2 * wid + 1) + fr) * 128 + 16 * mt + 4 * fq) = a1;
    }
    __syncthreads();
    u32x4 cpre[8]; u32x4 kpre;
    { const int tid_ = wid * 64 + lane;
#pragma unroll
      for (int i = 0; i < 8; ++i) { const int q = tid_ + 512 * i; cpre[i] = *(const u32x4*)(Cch + (q >> 4) * 128 + (q & 15) * 8); }
      kpre = *(const u32x4*)(Kc + tid_ * 8); }
    if (wid == 0) {
        const int p = lane; const float ar = A16[2 * p], ai = A16[2 * p + 1]; float hr = 0.f, hi = 0.f;
        float sr[8], si[8], tr[8], ti[8];
#pragma unroll
        for (int j = 0; j < 8; ++j) { sr[j] = S[j * 128 + p]; si[j] = S[j * 128 + 64 + p]; }
#pragma unroll 1
        for (int c0 = 0; c0 < 256; c0 += 8) {
            const int cn = (c0 + 8 < 256) ? c0 + 8 : c0;
#pragma unroll
            for (int j = 0; j < 8; ++j) { tr[j] = S[(cn + j) * 128 + p]; ti[j] = S[(cn + j) * 128 + 64 + p]; }
            asm volatile("s_waitcnt lgkmcnt(0)" ::: "memory");
#pragma unroll
            for (int j = 0; j < 8; ++j) {
                LAS bf16_t* Hrow = (LAS bf16_t*)(S + (c0 + j) * 128);
                Hrow[p] = f2bf(hr); Hrow[64 + p] = f2bf(hi);
                const float nr = ar * hr - ai * hi + sr[j], ni = ar * hi + ai * hr + si[j]; hr = nr; hi = ni;
            }
            asm volatile("" ::: "memory");
#pragma unroll
            for (int j = 0; j < 8; ++j) { sr[j] = tr[j]; si[j] = ti[j]; }
        }
    }
    __syncthreads();
    { const int tid_ = wid * 64 + lane;
#pragma unroll
      for (int i = 0; i < 8; ++i) { const int q = tid_ + 512 * i; *(LAS u32x4*)((LAS unsigned char*)S + (q >> 4) * 512 + 256 + (q & 15) * 16) = cpre[i]; }
      *(LAS u32x4*)(lds + 131072 + tid_ * 16) = kpre; }
    __syncthreads();
    bf16x8 hf[2][4];
#pragma unroll
    for (int n2 = 0; n2 < 2; ++n2)
#pragma unroll
        for (int ks = 0; ks < 4; ++ks) { const int c = 16 * (2 * wid + n2) + fr; hf[n2][ks] = *(const LAS bf16x8*)((const LAS unsigned char*)S + c * 512 + (32 * ks + 8 * fq) * 2); }
#define S5_LDA(kk, cc, t_) do { _Pragma("unroll") for (int ks = 0; ks <= ((t_) >> 1); ++ks) { const int jt = 2 * ks + (fq >> 1); const int tau = (t_) - jt; \
            kk[ks] = *(const LAS bf16x8*)(lds + 131072 + (((tau < 0 ? 0 : tau) * 16 + fr) * 16 + 8 * (fq & 1)) * 2); if (tau < 0) kk[ks] = (bf16x8){0, 0, 0, 0, 0, 0, 0, 0}; } \
        _Pragma("unroll") for (int ks = 0; ks < 4; ++ks) cc[ks] = *(const LAS bf16x8*)((const LAS unsigned char*)S + (16 * (t_) + fr) * 512 + 256 + (32 * ks + 8 * fq) * 2); } while (0)
    bf16x8 kcur[8], ccur[4];
    S5_LDA(kcur, ccur, 0);
#pragma unroll
    for (int t = 0; t < 16; ++t) {
        bf16x8 knx[8], cnx[4];
        if (t + 1 < 16) S5_LDA(knx, cnx, t + 1);
        f32x4 a0 = {0.f, 0.f, 0.f, 0.f}, a1 = {0.f, 0.f, 0.f, 0.f};
#pragma unroll
        for (int ks = 0; ks <= (t >> 1); ++ks) { a0 = MFMA16(kcur[ks], uf[0][ks], a0); a1 = MFMA16(kcur[ks], uf[1][ks], a1); }
#pragma unroll
        for (int ks = 0; ks < 4; ++ks) { a0 = MFMA16(ccur[ks], hf[0][ks], a0); a1 = MFMA16(ccur[ks], hf[1][ks], a1); }
        { const int c = 16 * (2 * wid) + fr; u32x2 w; w.x = pk2(gelu_exact(a0[0]), gelu_exact(a0[1])); w.y = pk2(gelu_exact(a0[2]), gelu_exact(a0[3]));
          if (ST) *(u32x2*)(Z + (tokb + 16 * c + t) * ZP + C_SIN + 16 * g + 4 * fq) = w; else *(LAS u32x2*)(lds + 139264 + lane * 16) = w; }
        { const int c = 16 * (2 * wid + 1) + fr; u32x2 w; w.x = pk2(gelu_exact(a1[0]), gelu_exact(a1[1])); w.y = pk2(gelu_exact(a1[2]), gelu_exact(a1[3]));
          if (ST) *(u32x2*)(Z + (tokb + 16 * c + t) * ZP + C_SIN + 16 * g + 4 * fq) = w; else *(LAS u32x2*)(lds + 139264 + lane * 16 + 8) = w; }
        if (t + 1 < 16) {
#pragma unroll
            for (int ks = 0; ks <= ((t + 1) >> 1); ++ks) kcur[ks] = knx[ks];
#pragma unroll
            for (int ks = 0; ks < 4; ++ks) ccur[ks] = cnx[ks]; }
    }
#undef S5_LDA
    __syncthreads();
}

template <bool ST> __device__ __forceinline__ void sgu_unit(LAS unsigned char* lds, bf16_t* Z, const bf16_t* Wm, const float* lng, const float* lnb, const float* bs, int b, int ch, int hd, int wid, int lane) {
    asm volatile("" : "+v"(lane));
    const size_t tok0 = (size_t)b * SEQ + (size_t)ch * 128;
    LAS bf16_t* vT = (LAS bf16_t*)lds;
    const int fr = lane & 15, fq = lane >> 4;
    {
        const int tt = lane >> 2, part = lane & 3, t = 16 * wid + tt;
        const bf16_t* rowp = Z + (tok0 + t) * ZP + C_GV + part * 8;
        u32x4 raw[16], hv[4];
#pragma unroll
        for (int jj = 0; jj < 16; ++jj) raw[jj] = *(const u32x4*)(rowp + jj * 32);
#pragma unroll
        for (int jj = 0; jj < 4; ++jj) hv[jj] = *(const u32x4*)(rowp + (4 * hd + jj) * 32);
        float s = 0.f;
#pragma unroll
        for (int jj = 0; jj < 16; ++jj) s += ((bflo(raw[jj].x) + bfhi(raw[jj].x)) + (bflo(raw[jj].y) + bfhi(raw[jj].y))) + ((bflo(raw[jj].z) + bfhi(raw[jj].z)) + (bflo(raw[jj].w) + bfhi(raw[jj].w)));
        s += __shfl_xor(s, 1); s += __shfl_xor(s, 2);
        const float mu = s * (1.f / 512.f); float q = 0.f;
#pragma unroll
        for (int jj = 0; jj < 16; ++jj) { float d;
            d = bflo(raw[jj].x) - mu; q += d * d; d = bfhi(raw[jj].x) - mu; q += d * d; d = bflo(raw[jj].y) - mu; q += d * d; d = bfhi(raw[jj].y) - mu; q += d * d;
            d = bflo(raw[jj].z) - mu; q += d * d; d = bfhi(raw[jj].z) - mu; q += d * d; d = bflo(raw[jj].w) - mu; q += d * d; d = bfhi(raw[jj].w) - mu; q += d * d; }
        q += __shfl_xor(q, 1); q += __shfl_xor(q, 2);
        const float rstd = rsqrtf(q * (1.f / 512.f) + 1e-5f);
#pragma unroll
        for (int jj = 0; jj < 4; ++jj) { const int e0 = jj * 32 + part * 8; const float* gp = lng + hd * 128 + e0; const float* bp = lnb + hd * 128 + e0;
            const f32x4 g0 = *(const f32x4*)gp, g1 = *(const f32x4*)(gp + 4), b0 = *(const f32x4*)bp, b1 = *(const f32x4*)(bp + 4);
            const float x[8] = {bflo(hv[jj].x), bfhi(hv[jj].x), bflo(hv[jj].y), bfhi(hv[jj].y), bflo(hv[jj].z), bfhi(hv[jj].z), bflo(hv[jj].w), bfhi(hv[jj].w)};
#pragma unroll
            for (int k = 0; k < 8; ++k) { const float gg = k < 4 ? g0[k & 3] : g1[k & 3], bb = k < 4 ? b0[k & 3] : b1[k & 3]; vT[(e0 + k) * 136 + t] = f2bf((x[k] - mu) * rstd * gg + bb); } }
    }
    u32x2 uu8[8], gt8[8];
#pragma unroll
    for (int nt = 0; nt < 8; ++nt) { const bf16_t* zq = Z + (tok0 + 16 * nt + fr) * ZP + hd * 128 + 16 * wid + 4 * fq;
        uu8[nt] = *(const u32x2*)(zq + C_GU); gt8[nt] = *(const u32x2*)(zq + C_GGATE); }
    bf16x8 bw[8][4];
#pragma unroll
    for (int nt = 0; nt < 8; ++nt)
#pragma unroll
        for (int ks = 0; ks <= (nt >> 1); ++ks) bw[nt][ks] = *(const bf16x8*)(Wm + hd * 16384 + (16 * nt + fr) * 128 + 32 * ks + 8 * fq);
    __syncthreads();
    bf16x8 af[4];
#pragma unroll
    for (int ks = 0; ks < 4; ++ks) af[ks] = *(const LAS bf16x8*)(vT + (16 * wid + fr) * 136 + 32 * ks + 8 * fq);
#pragma unroll
    for (int nt = 0; nt < 8; ++nt) {
        f32x4 acc = {0.f, 0.f, 0.f, 0.f};
#pragma unroll
        for (int ks = 0; ks <= (nt >> 1); ++ks) acc = MFMA16(af[ks], bw[nt][ks], acc);
        const int t = 16 * nt + fr; const int e = hd * 128 + 16 * wid + 4 * fq;
        bf16_t* zp = Z + (tok0 + t) * ZP + e;
        const u32x2 uu = uu8[nt], gt = gt8[nt]; const float bias = bs[hd * 128 + t];
        const float o0 = bflo(uu.x) * (acc[0] + bias) * siluf(bflo(gt.x)), o1 = bfhi(uu.x) * (acc[1] + bias) * siluf(bfhi(gt.x));
        const float o2 = bflo(uu.y) * (acc[2] + bias) * siluf(bflo(gt.y)), o3 = bfhi(uu.y) * (acc[3] + bias) * siluf(bfhi(gt.y));
        u32x2 w; w.x = pk2(o0, o1); w.y = pk2(o2, o3); if (ST) *(u32x2*)(zp + C_GU) = w; else *(LAS u32x2*)(lds + 139264 + lane * 16) = w;
    }
    __syncthreads();
}

typedef float f32x8v __attribute__((ext_vector_type(8)));
__device__ __forceinline__ f32x2_t pk_sub(f32x2_t a, f32x2_t b) { f32x2_t r; asm("v_pk_add_f32 %0, %1, %2 neg_lo:[0,1] neg_hi:[0,1]" : "=v"(r) : "v"(a), "v"(b)); return r; }
__device__ __forceinline__ float max3f(float a, float b, float c) { float r; asm("v_max3_f32 %0, %1, %2, %3" : "=v"(r) : "v"(a), "v"(b), "v"(c)); return r; }
__device__ __forceinline__ int crow(int i, int hh) { return (i & 3) + 8 * (i >> 2) + 4 * hh; }
template <bool ST> __device__ __forceinline__ void attn_qblock(LAS unsigned char* lds, bf16_t* Z, const bf16_t* VT, int b, int h, int qb, float lam, float oml, const float* subg, int tid, int wid, int lane) {
    asm volatile("" : "+v"(tid)); lane = tid & 63;
    const int c = wid >> 2, wq = wid & 3, l31 = lane & 31, hh = lane >> 5;
    const int q0 = qb * 128; const size_t tok0 = (size_t)b * SEQ;
    bf16x8 qf[4];
    { const bf16_t* qp = Z + (tok0 + q0 + 32 * wq + l31) * ZP + C_Q + h * 128 + c * 64 + 8 * hh;
#pragma unroll
      for (int ks = 0; ks < 4; ++ks) qf[ks] = *(const bf16x8*)(qp + 16 * ks); }
    f32x16 O[4];
#pragma unroll
    for (int d = 0; d < 4; ++d)
#pragma unroll
        for (int i = 0; i < 16; ++i) O[d][i] = 0.f;
    float mref = -1e30f, lsum = 0.f;
    const int nkt = 2 * qb + 2;
#define ATT_DMA(kt, sb) do { int t2 = tid; asm volatile("" : "+v"(t2)); const int krow = t2 >> 3, kch = (t2 & 7) ^ ((t2 >> 4) & 7); \
        const bf16_t* kg = Z + (tok0 + krow + (size_t)(kt) * 64) * ZP + C_K + h * 128 + kch * 8; \
        const bf16_t* vg = VT + ((size_t)(b * 1024 + h * 128 + krow)) * SEQ + kch * 8 + (kt) * 64; \
        LAS unsigned char* db = (sb) + wid * 1024; \
        __builtin_amdgcn_global_load_lds((const unsigned*)kg, (LAS unsigned*)(db), 16, 0, 0); \
        __builtin_amdgcn_global_load_lds((const unsigned*)(kg + 64), (LAS unsigned*)(db + 8192), 16, 0, 0); \
        __builtin_amdgcn_global_load_lds((const unsigned*)vg, (LAS unsigned*)(db + 16384), 16, 0, 0); \
        __builtin_amdgcn_global_load_lds((const unsigned*)(vg + (size_t)64 * SEQ), (LAS unsigned*)(db + 16384 + 8192), 16, 0, 0); } while (0)
    const int rsw = (l31 >> 1) & 7;
    const unsigned kro = (unsigned)(c * 8192 + l31 * 128), vro = (unsigned)(16384 + l31 * 128);
    unsigned cho[4];
#pragma unroll
    for (int j = 0; j < 4; ++j) { cho[j] = (unsigned)(((2 * j + hh) ^ rsw) * 16); }
    u32x4 pk[4];
    const int qrel = 32 * wq + l31;
#define ATT_MASKMAX(kt, A0, A1) \
        if ((kt) >= 2 * qb) { const int kb = 64 * ((kt) - 2 * qb); \
            _Pragma("unroll") for (int i = 0; i < 16; ++i) { const int kr = kb + crow(i, hh); if (kr > qrel) A0[i] = -1e30f; if (kr + 32 > qrel) A1[i] = -1e30f; } } \
        float mx; { float c0 = max3f(A0[0], A0[1], A0[2]), c1 = max3f(A0[8], A0[9], A0[10]), c2 = max3f(A1[0], A1[1], A1[2]), c3 = max3f(A1[8], A1[9], A1[10]); \
          c0 = max3f(c0, A0[3], A0[4]); c1 = max3f(c1, A0[11], A0[12]); c2 = max3f(c2, A1[3], A1[4]); c3 = max3f(c3, A1[11], A1[12]); \
          c0 = max3f(c0, A0[5], A0[6]); c1 = max3f(c1, A0[13], A0[14]); c2 = max3f(c2, A1[5], A1[6]); c3 = max3f(c3, A1[13], A1[14]); \
          c0 = max3f(c0, A0[7], c1); c2 = max3f(c2, A1[7], c3); c0 = max3f(c0, A0[15], A1[15]); c0 = max3f(c0, c2, c2); \
          const auto sw = __builtin_amdgcn_permlane32_swap(__float_as_uint(c0), __float_as_uint(c0), false, false); \
          const float e0 = __uint_as_float(sw[0]), e1 = __uint_as_float(sw[1]); mx = max3f(e0, e1, e1); } \
        float alpha = 1.f; const bool need = __builtin_amdgcn_ballot_w64(mx > mref + 8.f) != 0ull; \
        if (need) { const float mn = fmaxf(mref, mx); alpha = __builtin_amdgcn_exp2f(mref - mn); mref = mn; lsum *= alpha; }
#define ATT_EXP(A0, A1, PKN) \
        { const f32x2_t m2 = {mref, mref}; \
          _Pragma("unroll") for (int i = 0; i < 8; ++i) { f32x2_t t0 = {A0[2 * i], A0[2 * i + 1]}, t1 = {A1[2 * i], A1[2 * i + 1]}; t0 = pk_sub(t0, m2); t1 = pk_sub(t1, m2); \
              A0[2 * i] = t0.x; A0[2 * i + 1] = t0.y; A1[2 * i] = t1.x; A1[2 * i + 1] = t1.y; } } \
        _Pragma("unroll") for (int i = 0; i < 16; ++i) { A0[i] = __builtin_amdgcn_exp2f(A0[i]); A1[i] = __builtin_amdgcn_exp2f(A1[i]); } \
        { const f32x16 T = A0 + A1; \
          const f32x8v T8 = __builtin_shufflevector(T, T, 0, 1, 2, 3, 4, 5, 6, 7) + __builtin_shufflevector(T, T, 8, 9, 10, 11, 12, 13, 14, 15); \
          const f32x4 T4 = __builtin_shufflevector(T8, T8, 0, 1, 2, 3) + __builtin_shufflevector(T8, T8, 4, 5, 6, 7); \
          lsum += (T4[0] + T4[1]) + (T4[2] + T4[3]); } \
        _Pragma("unroll") for (int s = 0; s < 2; ++s) { const int o = 8 * s; \
            PKN[s].x = pk2(A0[o], A0[o + 1]); PKN[s].y = pk2(A0[o + 2], A0[o + 3]); PKN[s].z = pk2(A0[o + 4], A0[o + 5]); PKN[s].w = pk2(A0[o + 6], A0[o + 7]); \
            PKN[2 + s].x = pk2(A1[o], A1[o + 1]); PKN[2 + s].y = pk2(A1[o + 2], A1[o + 3]); PKN[2 + s].z = pk2(A1[o + 4], A1[o + 5]); PKN[2 + s].w = pk2(A1[o + 6], A1[o + 7]); }
#define VRD4(dst, sb, s) do { _Pragma("unroll") for (int d = 0; d < 4; ++d) dst[d] = *(const LAS bf16x8*)((sb) + vro + d * 4096 + cho[s]); } while (0)
#define KRD4(dst, sb, h2) do { _Pragma("unroll") for (int k2 = 0; k2 < 2; ++k2) { dst[2 * k2] = *(const LAS bf16x8*)((sb) + kro + cho[2 * (h2) + k2]); dst[2 * k2 + 1] = *(const LAS bf16x8*)((sb) + kro + 4096 + cho[2 * (h2) + k2]); } } while (0)
#define PV4(src, s, PK) do { const bf16x8 pf = __builtin_bit_cast(bf16x8, PK[s]); _Pragma("unroll") for (int d = 0; d < 4; ++d) O[d] = MFMA32(src[d], pf, O[d]); } while (0)
#define QK4A(src, B0, B1) do { B0 = MFMA32(src[0], qf[0], zero16); B1 = MFMA32(src[1], qf[0], zero16); B0 = MFMA32(src[2], qf[1], B0); B1 = MFMA32(src[3], qf[1], B1); } while (0)
#define QK4B(src, B0, B1) do { B0 = MFMA32(src[0], qf[2], B0); B1 = MFMA32(src[1], qf[2], B1); B0 = MFMA32(src[2], qf[3], B0); B1 = MFMA32(src[3], qf[3], B1); } while (0)
#define PIN(PKN) asm volatile("" : "+v"(PKN[0]), "+v"(PKN[1]), "+v"(PKN[2]), "+v"(PKN[3]), "+v"(lsum))
#define TAIL() do { if (need) { _Pragma("unroll") for (int d = 0; d < 4; ++d) O[d] = O[d] * alpha; } __syncthreads(); } while (0)
#define ATT_ITER(kt, A0, A1, B0, B1, PKP, PKN) do { \
        const LAS unsigned char* pst = lds + (((kt) + 3) & 3) * 32768; \
        const LAS unsigned char* nst = lds + (((kt) + 1) & 3) * 32768; \
        if ((kt) + 2 < nkt) ATT_DMA((kt) + 2, lds + (((kt) + 2) & 3) * 32768); \
        ATT_MASKMAX(kt, A0, A1) \
        __builtin_amdgcn_sched_barrier(0); \
        bf16x8 va[4], vb[4], ka[4], kb[4]; \
        VRD4(va, pst, 0); KRD4(ka, nst, 0); \
        PV4(va, 0, PKP); VRD4(vb, pst, 1); \
        QK4A(ka, B0, B1); KRD4(kb, nst, 1); \
        ATT_EXP(A0, A1, PKN) \
        PV4(vb, 1, PKP); VRD4(va, pst, 2); \
        QK4B(kb, B0, B1); \
        PV4(va, 2, PKP); VRD4(vb, pst, 3); \
        PV4(vb, 3, PKP); \
        PIN(PKN); \
        __builtin_amdgcn_sched_barrier(0); \
        TAIL(); } while (0)
    ATT_DMA(0, lds); ATT_DMA(1, lds + 32768);
    asm volatile("" :: "v"(qf[0]), "v"(qf[1]), "v"(qf[2]), "v"(qf[3]));
    __syncthreads();
    f32x16 zero16;
#pragma unroll
    for (int i = 0; i < 16; ++i) zero16[i] = 0.f;
    f32x16 S0, S1, N0, N1; u32x4 pkb[4];
    { bf16x8 ka[4], kb[4]; KRD4(ka, lds, 0); KRD4(kb, lds, 1); QK4A(ka, S0, S1); QK4B(kb, S0, S1); }
    asm volatile("s_nop 15\n\ts_nop 7" : "+v"(S0), "+v"(S1));
    {
        if (2 < nkt) ATT_DMA(2, lds + 2 * 32768);
        ATT_MASKMAX(0, S0, S1)
        const LAS unsigned char* nst = lds + 32768;
        __builtin_amdgcn_sched_barrier(0);
        bf16x8 ka[4], kb[4]; KRD4(ka, nst, 0); KRD4(kb, nst, 1);
        QK4A(ka, N0, N1);
        ATT_EXP(S0, S1, pk)
        QK4B(kb, N0, N1);
        PIN(pk);
        __builtin_amdgcn_sched_barrier(0);
        TAIL();
    }
#pragma unroll 1
    for (int kt = 1; kt + 1 < nkt; kt += 2) {
        ATT_ITER(kt, N0, N1, S0, S1, pk, pkb);
        ATT_ITER(kt + 1, S0, S1, N0, N1, pkb, pk);
    }
    {
        const int kt = nkt - 1;
        const LAS unsigned char* pst = lds + ((kt + 3) & 3) * 32768;
        ATT_MASKMAX(kt, N0, N1)
        __builtin_amdgcn_sched_barrier(0);
        bf16x8 va[4], vb[4];
        VRD4(va, pst, 0); VRD4(vb, pst, 1);
        PV4(va, 0, pk);
        ATT_EXP(N0, N1, pkb)
        PV4(vb, 1, pk); VRD4(va, pst, 2); VRD4(vb, pst, 3);
        PV4(va, 2, pk); PV4(vb, 3, pk);
        PIN(pkb);
        __builtin_amdgcn_sched_barrier(0);
        TAIL();
        const LAS unsigned char* lst = lds + (kt & 3) * 32768;
        VRD4(va, lst, 0); VRD4(vb, lst, 1); PV4(va, 0, pkb); PV4(vb, 1, pkb); VRD4(va, lst, 2); VRD4(vb, lst, 3); PV4(va, 2, pkb); PV4(vb, 3, pkb);
    }
    __syncthreads();
#undef VRD4
#undef KRD4
#undef PV4
#undef QK4A
#undef QK4B
#undef PIN
#undef TAIL
#undef ATT_ITER
#undef ATT_DMA
#undef ATT_MASKMAX
#undef ATT_EXP
    lsum += __shfl_xor(lsum, 32);
    const float inv = 1.f / lsum;
    LAS float* ox = (LAS float*)lds + wq * 4096;
    if (c == 1) {
#pragma unroll
        for (int d = 0; d < 4; ++d)
#pragma unroll
            for (int i = 0; i < 16; ++i) ox[(32 * d + crow(i, hh)) * 32 + l31] = O[d][i] * inv;
    }
    __syncthreads();
    if (c == 0) {
        float ss = 0.f;
#pragma unroll
        for (int d = 0; d < 4; ++d)
#pragma unroll
            for (int i = 0; i < 16; ++i) { const float o = O[d][i] * inv - lam * ox[(32 * d + crow(i, hh)) * 32 + l31]; O[d][i] = o; ss += o * o; }
        ss += __shfl_xor(ss, 32);
        const float rn = rsqrtf(ss * (1.f / 128.f) + 1e-6f) * oml;
        LAS bf16_t* TO = (LAS bf16_t*)(lds + 65536 + wq * 8704);
#pragma unroll
        for (int d = 0; d < 4; ++d)
#pragma unroll
            for (int g4 = 0; g4 < 4; ++g4) { const int dv0 = 32 * d + 8 * g4 + 4 * hh; const f32x4 sg = *(const f32x4*)(subg + dv0);
                u32x2 w; w.x = pk2(O[d][4 * g4] * rn * sg[0], O[d][4 * g4 + 1] * rn * sg[1]); w.y = pk2(O[d][4 * g4 + 2] * rn * sg[2], O[d][4 * g4 + 3] * rn * sg[3]);
                *(LAS u32x2*)(TO + l31 * 136 + dv0) = w; }
        asm volatile("s_waitcnt lgkmcnt(0)" ::: "memory");
#pragma unroll
        for (int rep = 0; rep < 8; ++rep) { const int p = lane + 64 * rep, row = p >> 4, c16 = p & 15;
            const u32x4 ov = *(const LAS u32x4*)(TO + row * 136 + c16 * 8);
            bf16_t* zp = Z + (tok0 + q0 + 32 * wq + row) * ZP + h * 128 + c16 * 8;
            const u32x4 gt = *(const u32x4*)(zp + C_AGATE);
            u32x4 w; w.x = pk2(bflo(ov.x) * siluf(bflo(gt.x)), bfhi(ov.x) * siluf(bfhi(gt.x))); w.y = pk2(bflo(ov.y) * siluf(bflo(gt.y)), bfhi(ov.y) * siluf(bfhi(gt.y)));
            w.z = pk2(bflo(ov.z) * siluf(bflo(gt.z)), bfhi(ov.z) * siluf(bfhi(gt.z))); w.w = pk2(bflo(ov.w) * siluf(bflo(gt.w)), bfhi(ov.w) * siluf(bfhi(gt.w)));
            if (ST) *(u32x4*)(zp + C_Q) = w; else *(LAS u32x4*)(lds + 139264 + lane * 16) = w; }
    }
    __syncthreads();
}

#define XB_TMO      128
#define XB_XCNT(j)  (256  + 64 * (j))
#define XB_XSUB(j)  (1280 + 64 * (j))
#define XB_XGEN(j)  (2304 + 64 * (j))
#define XB_TOP      3328
#define XB_TOPGEN   3392
#define XCD_BAR_WORDS 3456
#define XB_SPIN_CAP (1u << 22)
__device__ __forceinline__ unsigned xb_ld(unsigned* p)              { return __hip_atomic_load(p, __ATOMIC_RELAXED, __HIP_MEMORY_SCOPE_AGENT); }
__device__ __forceinline__ unsigned xb_add(unsigned* p, unsigned v) { return __hip_atomic_fetch_add(p, v, __ATOMIC_RELAXED, __HIP_MEMORY_SCOPE_AGENT); }
__device__ __forceinline__ unsigned xb_xcc_id() { return (unsigned)__builtin_amdgcn_s_getreg((3 << 11) | 20) & 0xFu; }
#define XB_SPIN(cond, bar) do { unsigned _sp = 0; while (cond) { __builtin_amdgcn_s_sleep(1); \
    if ((++_sp & 255u) == 0u) { if (xb_ld(&(bar)[XB_TMO])) break; if (_sp > XB_SPIN_CAP) { atomicAdd(&(bar)[XB_TMO], 1u); break; } } } } while (0)
struct XcdBarrier { unsigned* bar; unsigned x; volatile LAS unsigned* st; };
__device__ __forceinline__ XcdBarrier xcd_barrier_post(unsigned* bar, volatile LAS unsigned* st) {
    XcdBarrier b; b.bar = bar; b.x = xb_xcc_id(); b.st = st;
    if (threadIdx.x == 0) (void)xb_add(&bar[XB_XCNT(b.x)], 1u);
    return b;
}
__device__ __forceinline__ void xcd_barrier_complete(unsigned* bar, unsigned x, unsigned& nloc, unsigned& nx) {
    const unsigned G = gridDim.x * gridDim.y * gridDim.z;
    unsigned sum, cnt, mine, sp = 0u;
    for (;;) {
        sum = 0u; cnt = 0u; mine = 0u;
#pragma unroll
        for (unsigned j = 0; j < 16; ++j) { const unsigned c = xb_ld(&bar[XB_XCNT(j)]); sum += c; cnt += (c > 0u) ? 1u : 0u; mine = (j == x) ? c : mine; }
        if (sum == G) break;
        __builtin_amdgcn_s_sleep(1);
        if ((++sp & 255u) == 0u) { if (xb_ld(&bar[XB_TMO])) break; if (sp > XB_SPIN_CAP) { atomicAdd(&bar[XB_TMO], 1u); break; } }
    }
    nloc = mine > 0u ? mine : 1u; nx = cnt > 0u ? cnt : 1u;
}
__device__ __forceinline__ void xcd_barrier(const XcdBarrier& b) {
    asm volatile("s_waitcnt vmcnt(0)" ::: "memory");
    __syncthreads();
    if (threadIdx.x == 0) {
        unsigned* bar = b.bar;
        __builtin_amdgcn_s_waitcnt(0);
        unsigned nloc = b.st[0], nx = b.st[1];
        if (nloc == 0u) { xcd_barrier_complete(bar, b.x, nloc, nx); b.st[0] = nloc; b.st[1] = nx; }
        const unsigned old = xb_add(&bar[XB_XSUB(b.x)], 1u);
        const unsigned gen = old / nloc;
        if (old + 1u == (gen + 1u) * nloc) {
            __builtin_amdgcn_fence(__ATOMIC_RELEASE, "agent");
            asm volatile("s_waitcnt vmcnt(0)" ::: "memory");
            const unsigned og = xb_add(&bar[XB_TOP], 1u);
            const unsigned tg = og / nx;
            if (og + 1u == (tg + 1u) * nx) xb_add(&bar[XB_TOPGEN], 1u);
            else XB_SPIN(xb_ld(&bar[XB_TOPGEN]) == tg, bar);
            __builtin_amdgcn_fence(__ATOMIC_ACQUIRE, "agent");
            xb_add(&bar[XB_XGEN(b.x)], 1u);
            asm volatile("s_waitcnt vmcnt(0)" ::: "memory");
        } else {
            XB_SPIN(xb_ld(&bar[XB_XGEN(b.x)]) == gen, bar);
            __builtin_amdgcn_fence(__ATOMIC_ACQUIRE, "agent");
            asm volatile("s_waitcnt vmcnt(0)" ::: "memory");
        }
    }
    __syncthreads();
}
struct Params { const float* in[24]; float* out; unsigned char* ws; };

__global__ void __launch_bounds__(512, 2) mega_fwd(Params P) {
    extern __shared__ __attribute__((aligned(16))) unsigned char lds_raw[];
    LAS unsigned char* lds = (LAS unsigned char*)lds_raw;
    cg::grid_group grid = cg::this_grid();
    const int tid = threadIdx.x, lane = tid & 63, wid = __builtin_amdgcn_readfirstlane(tid >> 6);
    const int G = gridDim.x, bx = blockIdx.x;
    const int vcu = (G % 8 == 0) ? (bx % 8) * (G / 8) + bx / 8 : bx;
    const int gw = vcu * 8 + wid, NGW = G * 8;
    unsigned char* ws = P.ws;
    bf16_t* Z = (bf16_t*)(ws + OFF_Z); bf16_t* VT = (bf16_t*)(ws + OFF_VT); bf16_t* XB = (bf16_t*)(ws + OFF_XB);
    bf16_t* WinT = (bf16_t*)(ws + OFF_WIN); bf16_t* WoutT = (bf16_t*)(ws + OFF_WOUT); bf16_t* GluT = (bf16_t*)(ws + OFF_GLU);
    bf16_t* KC = (bf16_t*)(ws + OFF_KC); bf16_t* CCH = (bf16_t*)(ws + OFF_CCH); bf16_t* BCH = (bf16_t*)(ws + OFF_BCH); float* A16 = (float*)(ws + OFF_A16);
    float* part = (float*)(ws + OFF_PART); bf16_t* SGUW = (bf16_t*)(ws + OFF_SGUW); float* LAM = (float*)(ws + OFF_LAM);
    const float* x_in = P.in[0];
    unsigned* barw = (unsigned*)(ws + OFF_BAR);
    volatile LAS unsigned* bst = (volatile LAS unsigned*)(lds + LDS_BYTES - 16);
    if (tid == 0) { bst[0] = 0u; bst[1] = 0u; }
    __syncthreads();
    XcdBarrier xbar = xcd_barrier_post(barw, bst);
    if (P.ws == nullptr) grid.sync();
#define GSYNC() xcd_barrier(xbar)

#ifdef PROBE_P0X2
    for (int rep_ = 0; rep_ < 2; ++rep_) {
#else
    {
#endif
    conv_win(lds, P.in[2], P.in[1], WinT, gw, NGW, wid, lane);
    conv_plain(lds, P.in[11], 512, 512, GluT, gw, NGW, wid, lane);
    conv_plain(lds, P.in[11] + 512 * 512, 512, 512, GluT + 512 * 512, gw, NGW, wid, lane);
    __syncthreads();
#ifndef SKIP_S5P
    { S5In I{P.in[3], P.in[4], P.in[5], P.in[6], P.in[7], P.in[8], P.in[9], P.in[10]};
      for (int lg = vcu; lg < 64; lg += G) s5_params(lds, I, lg, KC, CCH, BCH, A16, tid); }
#endif
    for (int i = vcu * 512 + tid; i < 2 * 4 * 16384; i += G * 512) { const int t = (i >> 7) & 127, s = i & 127; SGUW[i] = f2bf(s <= t ? P.in[15][i] : 0.f); }
    if (bx == 0 && tid < 2) { const int l = tid; float d1 = 0.f, d2 = 0.f;
        for (int i = 0; i < 64; ++i) { d1 += P.in[17][l * 64 + i] * P.in[18][l * 64 + i]; d2 += P.in[19][l * 64 + i] * P.in[20][l * 64 + i]; }
        const float li = 0.8f - 0.6f * expf(-0.3f * (float)l); LAM[2 * l] = expf(d1) - expf(d2) + li; LAM[2 * l + 1] = 1.f - li; }
    for (int r0 = gw; r0 < T_TOK; r0 += 4 * NGW) {
        f32x4 v[4][4];
#pragma unroll
        for (int q = 0; q < 4; ++q) { const int r = r0 + q * NGW; if (r < T_TOK) { const f32x4* xr = (const f32x4*)(x_in + (size_t)r * DM) + lane;
#pragma unroll
            for (int j = 0; j < 4; ++j) v[q][j] = __builtin_nontemporal_load(xr + 64 * j); } }
#pragma unroll
        for (int q = 0; q < 4; ++q) { const int r = r0 + q * NGW; if (r < T_TOK) { float s = 0.f; u32x2* xo = (u32x2*)(XB + (size_t)r * DM) + lane;
#pragma unroll
            for (int j = 0; j < 4; ++j) { const f32x4 t = v[q][j]; s += (t[0] * t[0] + t[1] * t[1]) + (t[2] * t[2] + t[3] * t[3]); u32x2 w; w.x = pk2(t[0], t[1]); w.y = pk2(t[2], t[3]); xo[64 * j] = w; }
            s = wave_sum(s);
            if (lane < 16) part[(size_t)r * 16 + lane] = (lane == 0) ? s : 0.f; } }
    }
    __syncthreads();
    }
    GSYNC();

    for (int l = 0; l < 2; ++l) {
        conv_plain(lds, P.in[22] + (size_t)l * 2048 * 1024, 2048, 1024, WoutT, gw, NGW, wid, lane);
        __syncthreads();
        { pg8::Gemm g{XB, WinT, T_TOK, ZP, 1024, 1024, 1024}; pg8::StaticOrder S; S.init(T_TOK, ZP, G, bx); EpiIn E{Z, part};
          pg8::gemm_phase<EpiIn>(lds, g, S, E); }
#ifdef PROBE_P1X2
        { pg8::Gemm g{XB, WinT, T_TOK, ZP, 1024, 1024, 1024}; pg8::StaticOrder S; S.init(T_TOK, ZP, G, bx); EpiIn E{Z, part};
          pg8::gemm_phase<EpiIn>(lds, g, S, E); }
#endif
        { pg8::Gemm g{WinT + (size_t)ZP * 1024, XB, 1024, T_TOK, 1024, 1024, 1024}; pg8::StaticOrder S; S.init(1024, T_TOK, G, bx); EpiVT E{VT, part};
          pg8::gemm_phase<EpiVT>(lds, g, S, E); }
#ifdef PROBE_VTX2
        { pg8::Gemm g{WinT + (size_t)ZP * 1024, XB, 1024, T_TOK, 1024, 1024, 1024}; pg8::StaticOrder S; S.init(1024, T_TOK, G, bx); EpiVT E{VT, part};
          pg8::gemm_phase<EpiVT>(lds, g, S, E); }
#endif
        GSYNC();
#ifndef SKIP_S5
        for (int u = vcu; u < 256; u += G) { const int b = u >> 5, g = u & 31, lg = l * 32 + g;
            s5_unit<true>(lds, Z, KC + (size_t)lg * 4096, CCH + (size_t)lg * 32768, BCH + (size_t)lg * 32768, A16 + lg * 128, b, g, wid, lane); }
#endif
        {
          int nmine = 0; for (int u = vcu; u < 256; u += G) ++nmine;
          asm volatile("s_waitcnt vmcnt(0)" ::: "memory"); __syncthreads();
          if (tid == 0) { __builtin_amdgcn_fence(__ATOMIC_RELEASE, "agent"); asm volatile("s_waitcnt vmcnt(0)" ::: "memory");
              __hip_atomic_fetch_add(barw + 3600 + 64 * l, (unsigned)nmine, __ATOMIC_RELAXED, __HIP_MEMORY_SCOPE_AGENT); } }
#ifndef SKIP_SGU
        for (int u = vcu; u < 1024; u += G) { const int hd = u & 3, ch = (u >> 2) & 31, b = u >> 7;
            sgu_unit<true>(lds, Z, SGUW + (size_t)l * 65536, P.in[13] + l * 512, P.in[14] + l * 512, P.in[16] + l * 512, b, ch, hd, wid, lane); }
#endif
#ifdef PROBE_MIX2
        for (int u = vcu; u < 256; u += G) { const int b = u >> 5, g = u & 31, lg = l * 32 + g;
            s5_unit<false>(lds, Z, KC + (size_t)lg * 4096, CCH + (size_t)lg * 32768, BCH + (size_t)lg * 32768, A16 + lg * 128, b, g, wid, lane); }
        for (int u = vcu; u < 1024; u += G) { const int hd = u & 3, ch = (u >> 2) & 31, b = u >> 7;
            sgu_unit<false>(lds, Z, SGUW + (size_t)l * 65536, P.in[13] + l * 512, P.in[14] + l * 512, P.in[16] + l * 512, b, ch, hd, wid, lane); }
#endif
        { const float lam = LAM[2 * l], oml = LAM[2 * l + 1]; const float* subg = P.in[21] + l * 128;
#ifndef SKIP_ATT
          for (int u = vcu; u < 1024; u += G) { const int bh = u >> 4, pr = u & 15, b = bh >> 3, h = bh & 7;
              attn_qblock<true>(lds, Z, VT, b, h, 31 - pr, lam, oml, subg, tid, wid, lane);
              attn_qblock<true>(lds, Z, VT, b, h, pr, lam, oml, subg, tid, wid, lane); }
#endif
#ifdef PROBE_ATT2
          for (int u = vcu; u < 1024; u += G) { const int bh = u >> 4, pr = u & 15, b = bh >> 3, h = bh & 7;
              attn_qblock<false>(lds, Z, VT, b, h, 31 - pr, lam, oml, subg, tid, wid, lane);
              attn_qblock<false>(lds, Z, VT, b, h, pr, lam, oml, subg, tid, wid, lane); }
#endif
        }
        { asm volatile("s_waitcnt vmcnt(0)" ::: "memory"); __syncthreads();
          if (tid == 0) { unsigned sp = 0; while (__hip_atomic_load(barw + 3600 + 64 * l, __ATOMIC_RELAXED, __HIP_MEMORY_SCOPE_AGENT) < 256u) { __builtin_amdgcn_s_sleep(2); if (++sp > (1u << 24)) break; }
              __builtin_amdgcn_fence(__ATOMIC_ACQUIRE, "agent"); asm volatile("s_waitcnt vmcnt(0)" ::: "memory"); }
          __syncthreads(); }
        { pg8::Gemm g{Z + C_SIN, GluT + (size_t)l * 512 * 512, T_TOK, 512, 512, ZP, 512}; pg8::StaticOrder S; S.init(T_TOK, 512, G, bx); EpiGlu E{Z, P.in[12] + l * 512};
          pg8::gemm_phase<EpiGlu>(lds, g, S, E); }
        if (l == 0) { __syncthreads(); conv_win(lds, P.in[2] + (size_t)1024 * NIN, P.in[1] + 1024, WinT, gw, NGW, wid, lane); __syncthreads(); }
        GSYNC();
        if (l == 0) { pg8::Gemm g{Z, WoutT, T_TOK, DM, DMIX, ZP, DMIX}; pg8::StaticOrder S; S.init(T_TOK, DM, G, bx); EpiOut<false> E{x_in, P.out, XB, part};
          pg8::gemm_phase<EpiOut<false>>(lds, g, S, E); }
        else { pg8::Gemm g{Z, WoutT, T_TOK, DM, DMIX, ZP, DMIX}; pg8::StaticOrder S; S.init(T_TOK, DM, G, bx); EpiOut<true> E{P.out, P.out, XB, part};
          pg8::gemm_phase<EpiOut<true>>(lds, g, S, E); }
        GSYNC();
    }
#ifdef PROBE_SYNC20
    for (int i = 0; i < 20; ++i) GSYNC();
#endif
    for (int r0 = gw; r0 < T_TOK; r0 += 4 * NGW) {
        f32x4 v[4][4]; float ri[4];
#pragma unroll
        for (int q = 0; q < 4; ++q) { const int r = r0 + q * NGW; if (r < T_TOK) { ri[q] = row_rinv(part, r); const f32x4* xr = (const f32x4*)(P.out + (size_t)r * DM) + lane;
#pragma unroll
            for (int j = 0; j < 4; ++j) v[q][j] = xr[64 * j]; } }
        const f32x4* gg = (const f32x4*)P.in[23] + lane;
#pragma unroll
        for (int q = 0; q < 4; ++q) { const int r = r0 + q * NGW; if (r < T_TOK) { f32x4* xr = (f32x4*)(P.out + (size_t)r * DM) + lane;
#pragma unroll
            for (int j = 0; j < 4; ++j) __builtin_nontemporal_store(v[q][j] * ri[q] * gg[64 * j], xr + 64 * j); } }
    }
}

extern "C" void kernel_launch(void* const* d_in, const int* in_sizes, int n_in, void* d_out, int out_size, void* d_ws, size_t ws_size, hipStream_t stream) {
    static int grid_blocks = 0;
    if (!grid_blocks) {
        if (n_in != 24 || ws_size < WS_END) { fprintf(stderr, "kernel_launch: unexpected n_in %d / ws_size %zu (need %zu)\n", n_in, ws_size, (size_t)WS_END); grid_blocks = -1; return; }
        int dev = 0, cus = 0, per_cu = 0;
        hipGetDevice(&dev);
        hipDeviceGetAttribute(&cus, hipDeviceAttributeMultiprocessorCount, dev);
        hipFuncSetAttribute((const void*)mega_fwd, hipFuncAttributeMaxDynamicSharedMemorySize, LDS_BYTES);
        hipOccupancyMaxActiveBlocksPerMultiprocessor(&per_cu, (const void*)mega_fwd, 512, LDS_BYTES);
        if (per_cu < 1) { fprintf(stderr, "kernel_launch: occupancy query says %d blocks/CU\n", per_cu); per_cu = 1; }
        grid_blocks = cus * 1;
    }
    if (grid_blocks < 0) return;
    if (hipMemsetAsync((char*)d_ws + OFF_BAR, 0, 16384, stream) != hipSuccess) { fprintf(stderr, "kernel_launch: memset of the barrier words failed\n"); return; }
    Params p{};
    for (int i = 0; i < 24; ++i) p.in[i] = (const float*)d_in[i];
    p.out = (float*)d_out; p.ws = (unsigned char*)d_ws;
    void* args[] = {&p};
    hipError_t e = hipLaunchCooperativeKernel((const void*)mega_fwd, dim3(grid_blocks), dim3(512), args, LDS_BYTES, stream);
    if (e != hipSuccess) fprintf(stderr, "cooperative launch failed: %s (grid %d)\n", hipGetErrorString(e), grid_blocks);
}
```

```cpp
#include <hip/hip_runtime.h>
#include <hip/hip_cooperative_groups.h>
#include <cstdio>
#include <cstdint>
namespace cg = cooperative_groups;

#define LAS __attribute__((address_space(3)))
typedef unsigned short bf16_t;
typedef short bf16x8 __attribute__((ext_vector_type(8)));
typedef float f32x4 __attribute__((ext_vector_type(4)));
typedef float f32x16 __attribute__((ext_vector_type(16)));
typedef unsigned u32x4 __attribute__((ext_vector_type(4)));
typedef unsigned u32x2 __attribute__((ext_vector_type(2)));
typedef float f32x2_t __attribute__((ext_vector_type(2)));
typedef __bf16 bf16x2_t __attribute__((ext_vector_type(2)));

__device__ __forceinline__ unsigned pk2(float lo, float hi) { f32x2_t v = {lo, hi}; bf16x2_t b = __builtin_convertvector(v, bf16x2_t); return __builtin_bit_cast(unsigned, b); }
__device__ __forceinline__ float bflo(unsigned u) { return __uint_as_float(u << 16); }
__device__ __forceinline__ float bfhi(unsigned u) { return __uint_as_float(u & 0xffff0000u); }
__device__ __forceinline__ bf16_t f2bf(float f) { return (bf16_t)(pk2(f, 0.f) & 0xffffu); }
__device__ __forceinline__ float siluf(float x) { return x / (1.f + __expf(-x)); }
__device__ __forceinline__ float sigmf(float x) { return 1.f / (1.f + __expf(-x)); }
__device__ __forceinline__ float wave_sum(float v) {
#pragma unroll
    for (int o = 1; o < 64; o <<= 1) v += __shfl_xor(v, o);
    return v;
}
#define MFMA16(a, b, c) __builtin_amdgcn_mfma_f32_16x16x32_bf16((a), (b), (c), 0, 0, 0)
#define MFMA32(a, b, c) __builtin_amdgcn_mfma_f32_32x32x16_bf16((a), (b), (c), 0, 0, 0)

constexpr int T_TOK = 32768, DM = 1024, SEQ = 4096, NBATCH = 8, ZP = 5632, NIN = 6656, DMIX = 2048;
constexpr int C_SGATE = 0, C_GU = 512, C_Q = 1024, C_SIN = 2048, C_GV = 2560, C_GGATE = 3072, C_K = 3584, C_AGATE = 4608;
constexpr float C2 = 0.125f * 1.4426950408889634f;
constexpr size_t OFF_Z = 0, SZ_Z = (size_t)T_TOK * ZP * 2;
constexpr size_t OFF_VT = OFF_Z + SZ_Z, SZ_VT = (size_t)T_TOK * 1024 * 2;
constexpr size_t OFF_XB = OFF_VT + SZ_VT, SZ_XB = (size_t)T_TOK * 1024 * 2;
constexpr size_t OFF_WIN = OFF_XB + SZ_XB, SZ_WIN = (size_t)NIN * 1024 * 2;
constexpr size_t OFF_WOUT = OFF_WIN + SZ_WIN, SZ_WOUT = (size_t)1024 * 2048 * 2;
constexpr size_t OFF_GLU = OFF_WOUT + SZ_WOUT, SZ_GLU = (size_t)2 * 512 * 512 * 2;
constexpr size_t OFF_KC = OFF_GLU + SZ_GLU, SZ_KC = (size_t)64 * 4096 * 2;
constexpr size_t OFF_CCH = OFF_KC + SZ_KC, SZ_CCH = (size_t)64 * 32768 * 2;
constexpr size_t OFF_BCH = OFF_CCH + SZ_CCH, SZ_BCH = (size_t)64 * 32768 * 2;
constexpr size_t OFF_A16 = OFF_BCH + SZ_BCH, SZ_A16 = (size_t)64 * 64 * 8;
constexpr size_t OFF_PART = OFF_A16 + SZ_A16, SZ_PART = (size_t)T_TOK * 16 * 4;
constexpr size_t OFF_SGUW = OFF_PART + SZ_PART, SZ_SGUW = (size_t)2 * 4 * 128 * 128 * 2;
constexpr size_t OFF_LAM = OFF_SGUW + SZ_SGUW, OFF_BAR = OFF_LAM + 256, WS_END = OFF_BAR + 16384;
constexpr int LDS_BYTES = 147456;

namespace pg8 {
constexpr int BM = 256, BK = 64, HALF = 128, HTB = HALF * BK * 2, STAGE_BYTES = 8 * HTB, NXCD = 8, WGM = 8;
__host__ __device__ __forceinline__ int lds_byte(int r, int c) { const int st = (r >> 4) * 2 + (c >> 5), rr = r & 15, cc = c & 31, ob = rr * 64 + cc * 2; return st * 1024 + (ob ^ (((ob >> 9) & 1) << 5)); }
__host__ __device__ __forceinline__ void stage_rc(int b, int& R, int& C) { const int st = b / 1024, sb = b % 1024, swz = sb ^ (((sb >> 9) & 1) << 5); R = (st >> 1) * 16 + swz / 64; C = (st & 1) * 32 + (swz % 64) / 2; }
__host__ __device__ __forceinline__ int perm32(int rho) { const int n = rho >> 4, i = rho & 15; return 8 * (i >> 2) + 4 * n + (i & 3); }
__host__ __device__ __forceinline__ int permV(int rho) { const int n = rho >> 4, i = rho & 15, q = i >> 2, j = i & 3; return 16 * (q >> 1) + 8 * n + 4 * (q & 1) + j; }
struct Unit { int pm, pn; };
struct Gemm { const bf16_t* A; const bf16_t* Bt; int M, N, K, lda, ldb; };
struct StaticOrder {
    int nM, nN, nwg, G, c;
    __device__ void init(int M, int N, int G_, int c_) { nM = M / BM; nN = N / BM; nwg = nM * nN; G = G_; c = c_; }
    __device__ bool next(int i, Unit& u) const {
        const long L = (long)i * G + c; if (L >= nwg) return false;
        int wgid = (int)L; { const int q = nwg / NXCD, r = nwg % NXCD, xcd = wgid % NXCD, off = wgid / NXCD; wgid = (xcd < r ? xcd * (q + 1) : r * (q + 1) + (xcd - r) * q) + off; }
        const int nig = WGM * nN, gid = wgid / nig, fm = gid * WGM, gsz = (nM - fm) < WGM ? (nM - fm) : WGM;
        u.pm = fm + ((wgid % nig) % gsz); u.pn = (wgid % nig) / gsz; return true;
    }
};
template <class Epi>
__device__ __forceinline__ void gemm_phase(LAS unsigned char* lds, const Gemm g, const StaticOrder& S, const Epi& E) {
    int tid = threadIdx.x; asm volatile("" : "+v"(tid));
    const int wid = __builtin_amdgcn_readfirstlane(tid >> 6), lane = tid & 63, wr = wid >> 2, wc = wid & 3, fr = lane & 15, fq = lane >> 4;
    const int K = g.K, nt = K / BK;
    unsigned voffA[2], voffB[2];
#pragma unroll
    for (int i = 0; i < 2; ++i) { int R, C; stage_rc(tid * 16 + i * 8192, R, C);
        const int Rb = (Epi::PERM == 1) ? ((R & ~31) + perm32(R & 31)) : (Epi::PERM == 2) ? ((R & ~31) + permV(R & 31)) : R;
        voffA[i] = (unsigned)(R * g.lda + C) * 2u; voffB[i] = (unsigned)(Rb * g.ldb + C) * 2u; }
    const size_t kstep = (size_t)(BK * 2);
    const size_t hstepA = (size_t)HALF * g.lda * 2, hstepB = (size_t)HALF * g.ldb * 2;
    const size_t tstepA = 2 * hstepA, tstepB = 2 * hstepB;
    const unsigned ldsw = (unsigned)wid * 1024u;
    const int aoff = lds_byte(wr * 64 + fr, fq * 8), boff = lds_byte(wc * 32 + fr, fq * 8);
#define PG8_SA(b, h) (((b) * 2 + (h)) * HTB)
#define PG8_SB(b, h) ((4 + (b) * 2 + (h)) * HTB)
#define PG8_STAGE(bufoff, gbase, voff) do { _Pragma("unroll") for (int _i = 0; _i < 2; ++_i) \
        __builtin_amdgcn_global_load_lds((const unsigned*)((const char*)(gbase) + (voff)[_i]), (LAS unsigned*)(lds + (bufoff) + ldsw + _i * 8192), 16, 0, 0); } while (0)
#define PG8_LDA(dst, b, h) do { _Pragma("unroll") for (int m = 0; m < 4; ++m) _Pragma("unroll") for (int k = 0; k < 2; ++k) dst[m][k] = *(const LAS bf16x8*)(lds + PG8_SA(b, h) + aoff + m * 2048 + k * 1024); } while (0)
#define PG8_LDB(dst, b, h) do { _Pragma("unroll") for (int n = 0; n < 2; ++n) _Pragma("unroll") for (int k = 0; k < 2; ++k) dst[n][k] = *(const LAS bf16x8*)(lds + PG8_SB(b, h) + boff + n * 2048 + k * 1024); } while (0)
#define PG8_MMA(ai, bj, At, Bt) do { __builtin_amdgcn_s_setprio(1); _Pragma("unroll") for (int m = 0; m < 4; ++m) _Pragma("unroll") for (int n = 0; n < 2; ++n) _Pragma("unroll") for (int k = 0; k < 2; ++k) \
        acc[ai][bj][m][n] = __builtin_amdgcn_mfma_f32_16x16x32_bf16(Bt[n][k], At[m][k], acc[ai][bj][m][n], 0, 0, 0); __builtin_amdgcn_s_setprio(0); } while (0)
#define PG8_WAIT_V(n) asm volatile("s_waitcnt vmcnt(" #n ")" ::: "memory")
#define PG8_WAIT_L(n) asm volatile("s_waitcnt lgkmcnt(" #n ")" ::: "memory")
#define PG8_BAR __builtin_amdgcn_s_barrier()
#define PG8_SCHED __builtin_amdgcn_sched_barrier(0)
    Unit cur, nxt; int ui = 0;
    if (!S.next(0, cur)) return;
    f32x4 acc[2][2][4][2];
#pragma unroll
    for (int a = 0; a < 2; ++a)
#pragma unroll
        for (int b = 0; b < 2; ++b)
#pragma unroll
            for (int m = 0; m < 4; ++m)
#pragma unroll
                for (int n = 0; n < 2; ++n) acc[a][b][m][n] = (f32x4){0.f, 0.f, 0.f, 0.f};
    bf16x8 At[4][2], B0[2][2], B1[2][2];
    const char* cA = (const char*)g.A + (size_t)cur.pm * tstepA; const char* cB = (const char*)g.Bt + (size_t)cur.pn * tstepB;
    PG8_STAGE(PG8_SB(0, 0), cB, voffB); PG8_STAGE(PG8_SB(0, 1), cB + hstepB, voffB); PG8_STAGE(PG8_SA(0, 0), cA, voffA); PG8_STAGE(PG8_SA(0, 1), cA + hstepA, voffA);
    if (wr == 1) PG8_BAR;
    PG8_WAIT_V(2); PG8_BAR;
    PG8_STAGE(PG8_SB(1, 0), cB + kstep, voffB); PG8_STAGE(PG8_SA(1, 0), cA + kstep, voffA); PG8_STAGE(PG8_SB(1, 1), cB + hstepB + kstep, voffB);
    PG8_WAIT_V(6); PG8_BAR;
    for (;;) {
        const bool has_next = S.next(ui + 1, nxt);
        const char* nA = has_next ? (const char*)g.A + (size_t)nxt.pm * tstepA : cA; const char* nB = has_next ? (const char*)g.Bt + (size_t)nxt.pn * tstepB : cB;
        for (int t = 0; t < nt; t += 2) {
            const bool last = (t == nt - 2);
            const char* a1 = cA + (size_t)(t + 1) * kstep;
            const char* a2 = last ? nA : cA + (size_t)(t + 2) * kstep; const char* b2 = last ? nB : cB + (size_t)(t + 2) * kstep;
            const char* a3 = a2 + kstep; const char* b3 = b2 + kstep;
            PG8_LDB(B0, 0, 0); PG8_LDB(B1, 0, 1); PG8_SCHED; PG8_LDA(At, 0, 0); PG8_STAGE(PG8_SA(1, 1), a1 + hstepA, voffA);
            PG8_WAIT_V(8); PG8_WAIT_L(0); PG8_BAR; PG8_MMA(0, 0, At, B0); PG8_MMA(0, 1, At, B1); PG8_BAR; PG8_SCHED;
            PG8_LDA(At, 0, 1); PG8_STAGE(PG8_SB(0, 0), b2, voffB); PG8_STAGE(PG8_SB(0, 1), b2 + hstepB, voffB); PG8_STAGE(PG8_SA(0, 0), a2, voffA);
            PG8_WAIT_V(8); PG8_WAIT_L(0); PG8_BAR; PG8_MMA(1, 0, At, B0); PG8_MMA(1, 1, At, B1); PG8_BAR; PG8_SCHED;
            PG8_LDB(B0, 1, 0); PG8_LDB(B1, 1, 1); PG8_SCHED; PG8_LDA(At, 1, 0); PG8_STAGE(PG8_SA(0, 1), a2 + hstepA, voffA);
            PG8_WAIT_V(8); PG8_WAIT_L(0); PG8_BAR; PG8_MMA(0, 0, At, B0); PG8_MMA(0, 1, At, B1); PG8_BAR; PG8_SCHED;
            PG8_LDA(At, 1, 1); PG8_STAGE(PG8_SB(1, 0), b3, voffB); PG8_STAGE(PG8_SB(1, 1), b3 + hstepB, voffB); PG8_STAGE(PG8_SA(1, 0), a3, voffA);
            PG8_WAIT_V(8); PG8_WAIT_L(0); PG8_BAR; PG8_MMA(1, 0, At, B0); PG8_MMA(1, 1, At, B1); PG8_BAR; PG8_SCHED;
        }
        if (wr == 0) PG8_BAR;
        E(acc, cur, wr, wc, fr, fq);
        if (!has_next) break;
#pragma unroll
        for (int a = 0; a < 2; ++a)
#pragma unroll
            for (int b = 0; b < 2; ++b)
#pragma unroll
                for (int m = 0; m < 4; ++m)
#pragma unroll
                    for (int n = 0; n < 2; ++n) acc[a][b][m][n] = (f32x4){0.f, 0.f, 0.f, 0.f};
        cur = nxt; cA = nA; cB = nB; ++ui;
        if (wr == 1) PG8_BAR;
    }
    PG8_WAIT_V(0);
    PG8_BAR;
#undef PG8_SA
#undef PG8_SB
#undef PG8_STAGE
#undef PG8_LDA
#undef PG8_LDB
#undef PG8_MMA
#undef PG8_WAIT_V
#undef PG8_WAIT_L
#undef PG8_BAR
#undef PG8_SCHED
}
}

typedef f32x4 AccT[2][2][4][2];
__device__ __forceinline__ float row_rinv(const float* part, int row) {
    const f32x4* p = (const f32x4*)(part + (size_t)row * 16);
    const f32x4 a = p[0], b = p[1], c = p[2], d = p[3];
    const float s = ((a[0] + a[1]) + (a[2] + a[3])) + ((b[0] + b[1]) + (b[2] + b[3])) + ((c[0] + c[1]) + (c[2] + c[3])) + ((d[0] + d[1]) + (d[2] + d[3]));
    return rsqrtf(s * (1.f / 1024.f) + 1e-6f);
}
struct EpiIn {
    static constexpr int PERM = 1;
    bf16_t* Z; const float* part;
    __device__ __forceinline__ void operator()(const AccT& acc, const pg8::Unit& u, int wr, int wc, int fr, int fq) const {
        const float qs = (u.pn >= 4 && u.pn < 8) ? C2 : 1.f;
#pragma unroll
        for (int ai = 0; ai < 2; ++ai)
#pragma unroll
            for (int m = 0; m < 4; ++m) {
                const int row = u.pm * 256 + ai * 128 + wr * 64 + m * 16 + fr;
                const float sc = row_rinv(part, row) * qs;
                bf16_t* rp = Z + (size_t)row * ZP + u.pn * 256 + wc * 32 + 8 * fq;
#pragma unroll
                for (int bj = 0; bj < 2; ++bj) { const f32x4 v0 = acc[ai][bj][m][0] * sc, v1 = acc[ai][bj][m][1] * sc;
                    u32x4 w; w.x = pk2(v0[0], v0[1]); w.y = pk2(v0[2], v0[3]); w.z = pk2(v1[0], v1[1]); w.w = pk2(v1[2], v1[3]);
                    __builtin_nontemporal_store(w, (u32x4*)(rp + bj * 128)); }
            }
    }
};
struct EpiVT {
    static constexpr int PERM = 2;
    bf16_t* VT; const float* part;
    __device__ __forceinline__ void operator()(const AccT& acc, const pg8::Unit& u, int wr, int wc, int fr, int fq) const {
#pragma unroll
        for (int bj = 0; bj < 2; ++bj) {
            const int g32 = u.pn * 256 + bj * 128 + wc * 32;
            const int t0 = g32 + 16 * (fq >> 1) + 4 * (fq & 1);
            f32x4 r0, r1;
            r0[0] = row_rinv(part, t0); r0[1] = row_rinv(part, t0 + 1); asm volatile("" : "+v"(r0[0]), "+v"(r0[1]));
            r0[2] = row_rinv(part, t0 + 2); r0[3] = row_rinv(part, t0 + 3); asm volatile("" : "+v"(r0[2]), "+v"(r0[3]));
            r1[0] = row_rinv(part, t0 + 8); r1[1] = row_rinv(part, t0 + 9); asm volatile("" : "+v"(r1[0]), "+v"(r1[1]));
            r1[2] = row_rinv(part, t0 + 10); r1[3] = row_rinv(part, t0 + 11); asm volatile("" : "+v"(r1[2]), "+v"(r1[3]));
            const int b = g32 >> 12, tp = (g32 & 4095) + 16 * (fq >> 1) + 8 * (fq & 1);
#pragma unroll
            for (int ai = 0; ai < 2; ++ai)
#pragma unroll
                for (int m = 0; m < 4; ++m) { const int ch = u.pm * 256 + ai * 128 + wr * 64 + m * 16 + fr;
                    const f32x4 v0 = acc[ai][bj][m][0] * r0, v1 = acc[ai][bj][m][1] * r1;
                    u32x4 w; w.x = pk2(v0[0], v0[1]); w.y = pk2(v0[2], v0[3]); w.z = pk2(v1[0], v1[1]); w.w = pk2(v1[2], v1[3]);
                    *(u32x4*)(VT + ((size_t)(b * 1024 + ch)) * SEQ + tp) = w; }
        }
    }
};
struct EpiGlu {
    static constexpr int PERM = 1;
    bf16_t* Z; const float* gb;
    __device__ __forceinline__ void operator()(const AccT& acc, const pg8::Unit& u, int wr, int wc, int fr, int fq) const {
#pragma unroll
        for (int ai = 0; ai < 2; ++ai)
#pragma unroll
            for (int m = 0; m < 4; ++m) {
                const int row = u.pm * 256 + ai * 128 + wr * 64 + m * 16 + fr;
#pragma unroll
                for (int bj = 0; bj < 2; ++bj) { const int col = u.pn * 256 + bj * 128 + wc * 32 + 8 * fq;
                    bf16_t* zp = Z + (size_t)row * ZP + col;
                    const u32x4 yp = *(const u32x4*)(zp + C_SIN), gt = *(const u32x4*)(zp + C_SGATE);
                    const f32x4 a0 = acc[ai][bj][m][0] + *(const f32x4*)(gb + col), a1 = acc[ai][bj][m][1] + *(const f32x4*)(gb + col + 4);
                    u32x4 w;
                    w.x = pk2(bflo(yp.x) * sigmf(a0[0]) * siluf(bflo(gt.x)), bfhi(yp.x) * sigmf(a0[1]) * siluf(bfhi(gt.x)));
                    w.y = pk2(bflo(yp.y) * sigmf(a0[2]) * siluf(bflo(gt.y)), bfhi(yp.y) * sigmf(a0[3]) * siluf(bfhi(gt.y)));
                    w.z = pk2(bflo(yp.z) * sigmf(a1[0]) * siluf(bflo(gt.z)), bfhi(yp.z) * sigmf(a1[1]) * siluf(bfhi(gt.z)));
                    w.w = pk2(bflo(yp.w) * sigmf(a1[2]) * siluf(bflo(gt.w)), bfhi(yp.w) * sigmf(a1[3]) * siluf(bfhi(gt.w)));
                    *(u32x4*)(zp + C_SGATE) = w; }
            }
    }
};
template <bool LAST> struct EpiOut {
    static constexpr int PERM = 1;
    const float* xold; float* out; bf16_t* XB; float* part;
    __device__ __forceinline__ void operator()(const AccT& acc, const pg8::Unit& u, int wr, int wc, int fr, int fq) const {
#pragma unroll
        for (int ai = 0; ai < 2; ++ai)
#pragma unroll
            for (int m = 0; m < 4; ++m) {
                const int row = u.pm * 256 + ai * 128 + wr * 64 + m * 16 + fr; float ss = 0.f;
#pragma unroll
                for (int bj = 0; bj < 2; ++bj)
#pragma unroll
                    for (int n = 0; n < 2; ++n) { const size_t o = (size_t)row * DM + u.pn * 256 + bj * 128 + wc * 32 + 8 * fq + 4 * n;
                        const f32x4 xn = *(const f32x4*)(xold + o) + acc[ai][bj][m][n];
                        *(f32x4*)(out + o) = xn; if (!LAST) { u32x2 w; w.x = pk2(xn[0], xn[1]); w.y = pk2(xn[2], xn[3]); *(u32x2*)(XB + o) = w; }
                        ss += (xn[0] * xn[0] + xn[1] * xn[1]) + (xn[2] * xn[2] + xn[3] * xn[3]); }
                ss += __shfl_xor(ss, 16); ss += __shfl_xor(ss, 32);
                if (fq == 0) part[(size_t)row * 16 + u.pn * 4 + wc] = ss;
            }
    }
};

__device__ __forceinline__ int remap_col(int n) {
    if (n < 512) return 512 + n;
    if (n < 1024) return 1024 + (n - 512);
    if (n < 2048) return 2560 + (n - 1024);
    if (n < 2560) return n - 2048;
    if (n < 3072) return 1536 + (n - 2560);
    if (n < 3584) return 2048 + (n - 3072);
    if (n < 4608) return n;
    if (n < 5632) return 5632 + (n - 4608);
    return 4608 + (n - 5632);
}
__device__ __forceinline__ void transpose_item(const float* W, int K, int N, int srcn0, const float* kscale, bf16_t* WT, int dstrow0, LAS float* scr, int k0, int lane) {
    asm volatile("" : "+v"(lane));
#pragma unroll 8
    for (int i = 0; i < 32; ++i) { const int kk = 2 * i + (lane >> 5); float v = W[(size_t)(k0 + kk) * N + srcn0 + (lane & 31)]; if (kscale) v *= kscale[k0 + kk]; scr[kk * 33 + (lane & 31)] = v; }
    asm volatile("s_waitcnt lgkmcnt(0)" ::: "memory");
    const int c = lane & 7;
#pragma unroll
    for (int j = 0; j < 4; ++j) { const int n = (lane >> 3) + 8 * j; const LAS float* s = scr + (8 * c) * 33 + n;
        u32x4 o; o.x = pk2(s[0 * 33], s[1 * 33]); o.y = pk2(s[2 * 33], s[3 * 33]); o.z = pk2(s[4 * 33], s[5 * 33]); o.w = pk2(s[6 * 33], s[7 * 33]);
        *(u32x4*)(WT + (size_t)(dstrow0 + n) * K + k0 + 8 * c) = o; }
    asm volatile("s_waitcnt lgkmcnt(0)" ::: "memory");
}
__device__ __forceinline__ void conv_win(LAS unsigned char* lds, const float* w_in_l, const float* g_l, bf16_t* WinT, int gw, int NGW, int wid, int lane) {
    LAS float* scr = (LAS float*)(lds + wid * 8448);
    for (int it = gw; it < 16 * 208; it += NGW) { const int kb = it / 208, nb = it % 208; transpose_item(w_in_l, 1024, NIN, remap_col(32 * nb), g_l, WinT, 32 * nb, scr, 64 * kb, lane); }
}
__device__ __forceinline__ void conv_plain(LAS unsigned char* lds, const float* W, int K, int N, bf16_t* WT, int gw, int NGW, int wid, int lane) {
    LAS float* scr = (LAS float*)(lds + wid * 8448);
    const int nbn = N / 32, nit = (K / 64) * nbn;
    for (int it = gw; it < nit; it += NGW) { const int kb = it / nbn, nb = it % nbn; transpose_item(W, K, N, 32 * nb, nullptr, WT, 32 * nb, scr, 64 * kb, lane); }
}
struct S5In { const float *a_re, *a_im, *lstep, *b_re, *b_im, *c_re, *c_im, *d; };
__device__ __forceinline__ void s5_params(LAS unsigned char* lds, const S5In& I, int lg, bf16_t* KcO, bf16_t* CchO, bf16_t* BchO, float* A16O, int tid) {
    asm volatile("" : "+v"(tid));
    typedef float f2 __attribute__((ext_vector_type(2)));
    LAS f2* pw = (LAS f2*)lds;
    LAS f2* Bb = (LAS f2*)(lds + 8704);
    LAS f2* Cc = (LAS f2*)(lds + 16896);
    if (tid < 64) {
        const int p = tid; const float lr = I.a_re[lg * 64 + p], li = I.a_im[lg * 64 + p], step = expf(I.lstep[lg]);
        const float mag = expf(step * lr), ang = step * li; float sn, cs; sincosf(ang, &sn, &cs);
        const float abr = mag * cs, abi = mag * sn;
        f2 w = {1.f, 0.f}; pw[p] = w;
#pragma unroll 1
        for (int t = 1; t <= 16; ++t) { const f2 n = {w.x * abr - w.y * abi, w.x * abi + w.y * abr}; w = n; pw[t * 64 + p] = w; }
        A16O[(lg * 64 + p) * 2] = w.x; A16O[(lg * 64 + p) * 2 + 1] = w.y;
        const float den = lr * lr + li * li, nr = abr - 1.f, ni = abi;
        const float cor = (nr * lr + ni * li) / den, coi = (ni * lr - nr * li) / den;
#pragma unroll 1
        for (int h = 0; h < 16; ++h) { const float br = I.b_re[(lg * 64 + p) * 16 + h], bi = I.b_im[(lg * 64 + p) * 16 + h]; const f2 v = {cor * br - coi * bi, cor * bi + coi * br}; Bb[p * 16 + h] = v; }
    }
#pragma unroll 1
    for (int i = tid; i < 1024; i += 512) { const f2 v = {I.c_re[lg * 1024 + i], I.c_im[lg * 1024 + i]}; Cc[i] = v; }
    __syncthreads();
#pragma unroll 1
    for (int e = tid; e < 4096; e += 512) { const int t = e >> 8, h = (e >> 4) & 15, h2 = e & 15; float a = 0.f;
#pragma unroll 4
        for (int p = 0; p < 64; ++p) { const f2 w = pw[t * 64 + p], cc = Cc[h * 64 + p], bb = Bb[p * 16 + h2]; const float tr = cc.x * w.x - cc.y * w.y, ti = cc.x * w.y + cc.y * w.x; a += tr * bb.x - ti * bb.y; }
        if (t == 0 && h == h2) a += I.d[(lg >> 5) * 512 + (lg & 31) * 16 + h];
        KcO[(size_t)lg * 4096 + e] = f2bf(a); }
#pragma unroll 2
    for (int e = tid; e < 32768; e += 512) { const int r = e >> 7, p2 = e & 127, t = r >> 4, h = r & 15, p = p2 & 63;
        const f2 w = pw[(t + 1) * 64 + p], cc = Cc[h * 64 + p]; const float Wr = cc.x * w.x - cc.y * w.y, Wi = cc.x * w.y + cc.y * w.x;
        CchO[(size_t)lg * 32768 + e] = f2bf(p2 < 64 ? Wr : -Wi); }
#pragma unroll 2
    for (int e = tid; e < 32768; e += 512) { const int p2 = e >> 8, k = e & 255, j = k >> 4, h2 = k & 15, p = p2 & 63;
        const f2 w = pw[(15 - j) * 64 + p], bb = Bb[p * 16 + h2]; const float Gr = w.x * bb.x - w.y * bb.y, Gi = w.x * bb.y + w.y * bb.x;
        BchO[(size_t)lg * 32768 + e] = f2bf(p2 < 64 ? Gr : Gi); }
    __syncthreads();
}

__device__ __forceinline__ float gelu_exact(float y) { return 0.5f * y * (1.f + erff(y * 0.70710678118654752f)); }
template <bool ST> __device__ __forceinline__ void s5_unit(LAS unsigned char* lds, bf16_t* Z, const bf16_t* Kc, const bf16_t* Cch, const bf16_t* Bch, const float* A16, int b, int g, int wid, int lane) {
    asm volatile("" : "+v"(lane));
    const int fr = lane & 15, fq = lane >> 4;
    LAS float* S = (LAS float*)lds;
    const size_t tokb = (size_t)b * SEQ;
    bf16x8 uf[2][8];
#pragma unroll
    for (int n2 = 0; n2 < 2; ++n2)
#pragma unroll
        for (int ks = 0; ks < 8; ++ks) { const int c = 16 * (2 * wid + n2) + fr;
            uf[n2][ks] = *(const bf16x8*)(Z + (tokb + 16 * c + 2 * ks + (fq >> 1)) * ZP + C_SIN + 16 * g + 8 * (fq & 1)); }
#pragma unroll 2
    for (int mt = 0; mt < 8; ++mt) {
        f32x4 a0 = {0.f, 0.f, 0.f, 0.f}, a1 = {0.f, 0.f, 0.f, 0.f};
#pragma unroll
        for (int ks = 0; ks < 8; ++ks) { const bf16x8 a = *(const bf16x8*)(Bch + (16 * mt + fr) * 256 + 32 * ks + 8 * fq); a0 = MFMA16(a, uf[0][ks], a0); a1 = MFMA16(a, uf[1][ks], a1); }
        *(LAS f32x4*)(S + (16 * (2 * wid) + fr) * 128 + 16 * mt + 4 * fq) = a0;
        *(LAS f32x4*)(S + (16 * (2 * wid + 1) + fr) * 128 + 16 * mt + 4 * fq) = a1;
    }
    __syncthreads();
    u32x4 cpre[8]; u32x4 kpre;
    { const int tid_ = wid * 64 + lane;
#pragma unroll
      for (int i = 0; i < 8; ++i) { const int q = tid_ + 512 * i; cpre[i] = *(const u32x4*)(Cch + (q >> 4) * 128 + (q & 15) * 8); }
      kpre = *(const u32x4*)(Kc + tid_ * 8); }
    if (wid == 0) {
        const int p = lane; const float ar = A16[2 * p], ai = A16[2 * p + 1]; float hr = 0.f, hi = 0.f;
        float sr[8], si[8], tr[8], ti[8];
#pragma unroll
        for (int j = 0; j < 8; ++j) { sr[j] = S[j * 128 + p]; si[j] = S[j * 128 + 64 + p]; }
#pragma unroll 1
        for (int c0 = 0; c0 < 256; c0 += 8) {
            const int cn = (c0 + 8 < 256) ? c0 + 8 : c0;
#pragma unroll
            for (int j = 0; j < 8; ++j) { tr[j] = S[(cn + j) * 128 + p]; ti[j] = S[(cn + j) * 128 + 64 + p]; }
            asm volatile("s_waitcnt lgkmcnt(0)" ::: "memory");
#pragma unroll
            for (int j = 0; j < 8; ++j) {
                LAS bf16_t* Hrow = (LAS bf16_t*)(S + (c0 + j) * 128);
                Hrow[p] = f2bf(hr); Hrow[64 + p] = f2bf(hi);
                const float nr = ar * hr - ai * hi + sr[j], ni = ar * hi + ai * hr + si[j]; hr = nr; hi = ni;
            }
            asm volatile("" ::: "memory");
#pragma unroll
            for (int j = 0; j < 8; ++j) { sr[j] = tr[j]; si[j] = ti[j]; }
        }
    }
    __syncthreads();
    { const int tid_ = wid * 64 + lane;
#pragma unroll
      for (int i = 0; i < 8; ++i) { const int q = tid_ + 512 * i; *(LAS u32x4*)((LAS unsigned char*)S + (q >> 4) * 512 + 256 + (q & 15) * 16) = cpre[i]; }
      *(LAS u32x4*)(lds + 131072 + tid_ * 16) = kpre; }
    __syncthreads();
    bf16x8 hf[2][4];
#pragma unroll
    for (int n2 = 0; n2 < 2; ++n2)
#pragma unroll
        for (int ks = 0; ks < 4; ++ks) { const int c = 16 * (2 * wid + n2) + fr; hf[n2][ks] = *(const LAS bf16x8*)((const LAS unsigned char*)S + c * 512 + (32 * ks + 8 * fq) * 2); }
#define S5_LDA(kk, cc, t_) do { _Pragma("unroll") for (int ks = 0; ks <= ((t_) >> 1); ++ks) { const int jt = 2 * ks + (fq >> 1); const int tau = (t_) - jt; \
            kk[ks] = *(const LAS bf16x8*)(lds + 131072 + (((tau < 0 ? 0 : tau) * 16 + fr) * 16 + 8 * (fq & 1)) * 2); if (tau < 0) kk[ks] = (bf16x8){0, 0, 0, 0, 0, 0, 0, 0}; } \
        _Pragma("unroll") for (int ks = 0; ks < 4; ++ks) cc[ks] = *(const LAS bf16x8*)((const LAS unsigned char*)S + (16 * (t_) + fr) * 512 + 256 + (32 * ks + 8 * fq) * 2); } while (0)
    bf16x8 kcur[8], ccur[4];
    S5_LDA(kcur, ccur, 0);
#pragma unroll
    for (int t = 0; t < 16; ++t) {
        bf16x8 knx[8], cnx[4];
        if (t + 1 < 16) S5_LDA(knx, cnx, t + 1);
        f32x4 a0 = {0.f, 0.f, 0.f, 0.f}, a1 = {0.f, 0.f, 0.f, 0.f};
#pragma unroll
        for (int ks = 0; ks <= (t >> 1); ++ks) { a0 = MFMA16(kcur[ks], uf[0][ks], a0); a1 = MFMA16(kcur[ks], uf[1][ks], a1); }
#pragma unroll
        for (int ks = 0; ks < 4; ++ks) { a0 = MFMA16(ccur[ks], hf[0][ks], a0); a1 = MFMA16(ccur[ks], hf[1][ks], a1); }
        { const int c = 16 * (2 * wid) + fr; u32x2 w; w.x = pk2(gelu_exact(a0[0]), gelu_exact(a0[1])); w.y = pk2(gelu_exact(a0[2]), gelu_exact(a0[3]));
          if (ST) *(u32x2*)(Z + (tokb + 16 * c + t) * ZP + C_SIN + 16 * g + 4 * fq) = w; else *(LAS u32x2*)(lds + 139264 + lane * 16) = w; }
        { const int c = 16 * (2 * wid + 1) + fr; u32x2 w; w.x = pk2(gelu_exact(a1[0]), gelu_exact(a1[1])); w.y = pk2(gelu_exact(a1[2]), gelu_exact(a1[3]));
          if (ST) *(u32x2*)(Z + (tokb + 16 * c + t) * ZP + C_SIN + 16 * g + 4 * fq) = w; else *(LAS u32x2*)(lds + 139264 + lane * 16 + 8) = w; }
        if (t + 1 < 16) {
#pragma unroll
            for (int ks = 0; ks <= ((t + 1) >> 1); ++ks) kcur[ks] = knx[ks];
#pragma unroll
            for (int ks = 0; ks < 4; ++ks) ccur[ks] = cnx[ks]; }
    }
#undef S5_LDA
    __syncthreads();
}

template <bool ST> __device__ __forceinline__ void sgu_unit(LAS unsigned char* lds, bf16_t* Z, const bf16_t* Wm, const float* lng, const float* lnb, const float* bs, int b, int ch, int hd, int wid, int lane) {
    asm volatile("" : "+v"(lane));
    const size_t tok0 = (size_t)b * SEQ + (size_t)ch * 128;
    LAS bf16_t* vT = (LAS bf16_t*)lds;
    const int fr = lane & 15, fq = lane >> 4;
    {
        const int tt = lane >> 2, part = lane & 3, t = 16 * wid + tt;
        const bf16_t* rowp = Z + (tok0 + t) * ZP + C_GV + part * 8;
        u32x4 raw[16], hv[4];
#pragma unroll
        for (int jj = 0; jj < 16; ++jj) raw[jj] = *(const u32x4*)(rowp + jj * 32);
#pragma unroll
        for (int jj = 0; jj < 4; ++jj) hv[jj] = *(const u32x4*)(rowp + (4 * hd + jj) * 32);
        float s = 0.f;
#pragma unroll
        for (int jj = 0; jj < 16; ++jj) s += ((bflo(raw[jj].x) + bfhi(raw[jj].x)) + (bflo(raw[jj].y) + bfhi(raw[jj].y))) + ((bflo(raw[jj].z) + bfhi(raw[jj].z)) + (bflo(raw[jj].w) + bfhi(raw[jj].w)));
        s += __shfl_xor(s, 1); s += __shfl_xor(s, 2);
        const float mu = s * (1.f / 512.f); float q = 0.f;
#pragma unroll
        for (int jj = 0; jj < 16; ++jj) { float d;
            d = bflo(raw[jj].x) - mu; q += d * d; d = bfhi(raw[jj].x) - mu; q += d * d; d = bflo(raw[jj].y) - mu; q += d * d; d = bfhi(raw[jj].y) - mu; q += d * d;
            d = bflo(raw[jj].z) - mu; q += d * d; d = bfhi(raw[jj].z) - mu; q += d * d; d = bflo(raw[jj].w) - mu; q += d * d; d = bfhi(raw[jj].w) - mu; q += d * d; }
        q += __shfl_xor(q, 1); q += __shfl_xor(q, 2);
        const float rstd = rsqrtf(q * (1.f / 512.f) + 1e-5f);
#pragma unroll
        for (int jj = 0; jj < 4; ++jj) { const int e0 = jj * 32 + part * 8; const float* gp = lng + hd * 128 + e0; const float* bp = lnb + hd * 128 + e0;
            const f32x4 g0 = *(const f32x4*)gp, g1 = *(const f32x4*)(gp + 4), b0 = *(const f32x4*)bp, b1 = *(const f32x4*)(bp + 4);
            const float x[8] = {bflo(hv[jj].x), bfhi(hv[jj].x), bflo(hv[jj].y), bfhi(hv[jj].y), bflo(hv[jj].z), bfhi(hv[jj].z), bflo(hv[jj].w), bfhi(hv[jj].w)};
#pragma unroll
            for (int k = 0; k < 8; ++k) { const float gg = k < 4 ? g0[k & 3] : g1[k & 3], bb = k < 4 ? b0[k & 3] : b1[k & 3]; vT[(e0 + k) * 136 + t] = f2bf((x[k] - mu) * rstd * gg + bb); } }
    }
    u32x2 uu8[8], gt8[8];
#pragma unroll
    for (int nt = 0; nt < 8; ++nt) { const bf16_t* zq = Z + (tok0 + 16 * nt + fr) * ZP + hd * 128 + 16 * wid + 4 * fq;
        uu8[nt] = *(const u32x2*)(zq + C_GU); gt8[nt] = *(const u32x2*)(zq + C_GGATE); }
    bf16x8 bw[8][4];
#pragma unroll
    for (int nt = 0; nt < 8; ++nt)
#pragma unroll
        for (int ks = 0; ks <= (nt >> 1); ++ks) bw[nt][ks] = *(const bf16x8*)(Wm + hd * 16384 + (16 * nt + fr) * 128 + 32 * ks + 8 * fq);
    __syncthreads();
    bf16x8 af[4];
#pragma unroll
    for (int ks = 0; ks < 4; ++ks) af[ks] = *(const LAS bf16x8*)(vT + (16 * wid + fr) * 136 + 32 * ks + 8 * fq);
#pragma unroll
    for (int nt = 0; nt < 8; ++nt) {
        f32x4 acc = {0.f, 0.f, 0.f, 0.f};
#pragma unroll
        for (int ks = 0; ks <= (nt >> 1); ++ks) acc = MFMA16(af[ks], bw[nt][ks], acc);
        const int t = 16 * nt + fr; const int e = hd * 128 + 16 * wid + 4 * fq;
        bf16_t* zp = Z + (tok0 + t) * ZP + e;
        const u32x2 uu = uu8[nt], gt = gt8[nt]; const float bias = bs[hd * 128 + t];
        const float o0 = bflo(uu.x) * (acc[0] + bias) * siluf(bflo(gt.x)), o1 = bfhi(uu.x) * (acc[1] + bias) * siluf(bfhi(gt.x));
        const float o2 = bflo(uu.y) * (acc[2] + bias) * siluf(bflo(gt.y)), o3 = bfhi(uu.y) * (acc[3] + bias) * siluf(bfhi(gt.y));
        u32x2 w; w.x = pk2(o0, o1); w.y = pk2(o2, o3); if (ST) *(u32x2*)(zp + C_GU) = w; else *(LAS u32x2*)(lds + 139264 + lane * 16) = w;
    }
    __syncthreads();
}

typedef float f32x8v __attribute__((ext_vector_type(8)));
__device__ __forceinline__ f32x2_t pk_sub(f32x2_t a, f32x2_t b) { f32x2_t r; asm("v_pk_add_f32 %0, %1, %2 neg_lo:[0,1] neg_hi:[0,1]" : "=v"(r) : "v"(a), "v"(b)); return r; }
__device__ __forceinline__ float max3f(float a, float b, float c) { float r; asm("v_max3_f32 %0, %1, %2, %3" : "=v"(r) : "v"(a), "v"(b), "v"(c)); return r; }
__device__ __forceinline__ int crow(int i, int hh) { return (i & 3) + 8 * (i >> 2) + 4 * hh; }
template <bool ST> __device__ __forceinline__ void attn_qblock(LAS unsigned char* lds, bf16_t* Z, const bf16_t* VT, int b, int h, int qb, float lam, float oml, const float* subg, int tid, int wid, int lane) {
    asm volatile("" : "+v"(tid)); lane = tid & 63;
    const int c = wid >> 2, wq = wid & 3, l31 = lane & 31, hh = lane >> 5;
    const int q0 = qb * 128; const size_t tok0 = (size_t)b * SEQ;
    bf16x8 qf[4];
    { const bf16_t* qp = Z + (tok0 + q0 + 32 * wq + l31) * ZP + C_Q + h * 128 + c * 64 + 8 * hh;
#pragma unroll
      for (int ks = 0; ks < 4; ++ks) qf[ks] = *(const bf16x8*)(qp + 16 * ks); }
    f32x16 O[4];
#pragma unroll
    for (int d = 0; d < 4; ++d)
#pragma unroll
        for (int i = 0; i < 16; ++i) O[d][i] = 0.f;
    float mref = -1e30f, lsum = 0.f;
    const int nkt = 2 * qb + 2;
#define ATT_DMA(kt, sb) do { int t2 = tid; asm volatile("" : "+v"(t2)); const int krow = t2 >> 3, kch = (t2 & 7) ^ ((t2 >> 4) & 7); \
        const bf16_t* kg = Z + (tok0 + krow + (size_t)(kt) * 64) * ZP + C_K + h * 128 + kch * 8; \
        const bf16_t* vg = VT + ((size_t)(b * 1024 + h * 128 + krow)) * SEQ + kch * 8 + (kt) * 64; \
        LAS unsigned char* db = (sb) + wid * 1024; \
        __builtin_amdgcn_global_load_lds((const unsigned*)kg, (LAS unsigned*)(db), 16, 0, 0); \
        __builtin_amdgcn_global_load_lds((const unsigned*)(kg + 64), (LAS unsigned*)(db + 8192), 16, 0, 0); \
        __builtin_amdgcn_global_load_lds((const unsigned*)vg, (LAS unsigned*)(db + 16384), 16, 0, 0); \
        __builtin_amdgcn_global_load_lds((const unsigned*)(vg + (size_t)64 * SEQ), (LAS unsigned*)(db + 16384 + 8192), 16, 0, 0); } while (0)
    const int rsw = (l31 >> 1) & 7;
    const unsigned kro = (unsigned)(c * 8192 + l31 * 128), vro = (unsigned)(16384 + l31 * 128);
    unsigned cho[4];
#pragma unroll
    for (int j = 0; j < 4; ++j) { cho[j] = (unsigned)(((2 * j + hh) ^ rsw) * 16); }
    u32x4 pk[4];
    const int qrel = 32 * wq + l31;
#define ATT_MASKMAX(kt, A0, A1) \
        if ((kt) >= 2 * qb) { const int kb = 64 * ((kt) - 2 * qb); \
            _Pragma("unroll") for (int i = 0; i < 16; ++i) { const int kr = kb + crow(i, hh); if (kr > qrel) A0[i] = -1e30f; if (kr + 32 > qrel) A1[i] = -1e30f; } } \
        float mx; { float c0 = max3f(A0[0], A0[1], A0[2]), c1 = max3f(A0[8], A0[9], A0[10]), c2 = max3f(A1[0], A1[1], A1[2]), c3 = max3f(A1[8], A1[9], A1[10]); \
          c0 = max3f(c0, A0[3], A0[4]); c1 = max3f(c1, A0[11], A0[12]); c2 = max3f(c2, A1[3], A1[4]); c3 = max3f(c3, A1[11], A1[12]); \
          c0 = max3f(c0, A0[5], A0[6]); c1 = max3f(c1, A0[13], A0[14]); c2 = max3f(c2, A1[5], A1[6]); c3 = max3f(c3, A1[13], A1[14]); \
          c0 = max3f(c0, A0[7], c1); c2 = max3f(c2, A1[7], c3); c0 = max3f(c0, A0[15], A1[15]); c0 = max3f(c0, c2, c2); \
          const auto sw = __builtin_amdgcn_permlane32_swap(__float_as_uint(c0), __float_as_uint(c0), false, false); \
          const float e0 = __uint_as_float(sw[0]), e1 = __uint_as_float(sw[1]); mx = max3f(e0, e1, e1); } \
        float alpha = 1.f; const bool need = __builtin_amdgcn_ballot_w64(mx > mref + 8.f) != 0ull; \
        if (need) { const float mn = fmaxf(mref, mx); alpha = __builtin_amdgcn_exp2f(mref - mn); mref = mn; lsum *= alpha; }
#define ATT_EXP(A0, A1, PKN) \
        { const f32x2_t m2 = {mref, mref}; \
          _Pragma("unroll") for (int i = 0; i < 8; ++i) { f32x2_t t0 = {A0[2 * i], A0[2 * i + 1]}, t1 = {A1[2 * i], A1[2 * i + 1]}; t0 = pk_sub(t0, m2); t1 = pk_sub(t1, m2); \
              A0[2 * i] = t0.x; A0[2 * i + 1] = t0.y; A1[2 * i] = t1.x; A1[2 * i + 1] = t1.y; } } \
        _Pragma("unroll") for (int i = 0; i < 16; ++i) { A0[i] = __builtin_amdgcn_exp2f(A0[i]); A1[i] = __builtin_amdgcn_exp2f(A1[i]); } \
        { const f32x16 T = A0 + A1; \
          const f32x8v T8 = __builtin_shufflevector(T, T, 0, 1, 2, 3, 4, 5, 6, 7) + __builtin_shufflevector(T, T, 8, 9, 10, 11, 12, 13, 14, 15); \
          const f32x4 T4 = __builtin_shufflevector(T8, T8, 0, 1, 2, 3) + __builtin_shufflevector(T8, T8, 4, 5, 6, 7); \
          lsum += (T4[0] + T4[1]) + (T4[2] + T4[3]); } \
        _Pragma("unroll") for (int s = 0; s < 2; ++s) { const int o = 8 * s; \
            PKN[s].x = pk2(A0[o], A0[o + 1]); PKN[s].y = pk2(A0[o + 2], A0[o + 3]); PKN[s].z = pk2(A0[o + 4], A0[o + 5]); PKN[s].w = pk2(A0[o + 6], A0[o + 7]); \
            PKN[2 + s].x = pk2(A1[o], A1[o + 1]); PKN[2 + s].y = pk2(A1[o + 2], A1[o + 3]); PKN[2 + s].z = pk2(A1[o + 4], A1[o + 5]); PKN[2 + s].w = pk2(A1[o + 6], A1[o + 7]); }
#define VRD4(dst, sb, s) do { _Pragma("unroll") for (int d = 0; d < 4; ++d) dst[d] = *(const LAS bf16x8*)((sb) + vro + d * 4096 + cho[s]); } while (0)
#define KRD4(dst, sb, h2) do { _Pragma("unroll") for (int k2 = 0; k2 < 2; ++k2) { dst[2 * k2] = *(const LAS bf16x8*)((sb) + kro + cho[2 * (h2) + k2]); dst[2 * k2 + 1] = *(const LAS bf16x8*)((sb) + kro + 4096 + cho[2 * (h2) + k2]); } } while (0)
#define PV4(src, s, PK) do { const bf16x8 pf = __builtin_bit_cast(bf16x8, PK[s]); _Pragma("unroll") for (int d = 0; d < 4; ++d) O[d] = MFMA32(src[d], pf, O[d]); } while (0)
#define QK4A(src, B0, B1) do { B0 = MFMA32(src[0], qf[0], zero16); B1 = MFMA32(src[1], qf[0], zero16); B0 = MFMA32(src[2], qf[1], B0); B1 = MFMA32(src[3], qf[1], B1); } while (0)
#define QK4B(src, B0, B1) do { B0 = MFMA32(src[0], qf[2], B0); B1 = MFMA32(src[1], qf[2], B1); B0 = MFMA32(src[2], qf[3], B0); B1 = MFMA32(src[3], qf[3], B1); } while (0)
#define PIN(PKN) asm volatile("" : "+v"(PKN[0]), "+v"(PKN[1]), "+v"(PKN[2]), "+v"(PKN[3]), "+v"(lsum))
#define TAIL() do { if (need) { _Pragma("unroll") for (int d = 0; d < 4; ++d) O[d] = O[d] * alpha; } __syncthreads(); } while (0)
#define ATT_ITER(kt, A0, A1, B0, B1, PKP, PKN) do { \
        const LAS unsigned char* pst = lds + (((kt) + 3) & 3) * 32768; \
        const LAS unsigned char* nst = lds + (((kt) + 1) & 3) * 32768; \
        if ((kt) + 2 < nkt) ATT_DMA((kt) + 2, lds + (((kt) + 2) & 3) * 32768); \
        ATT_MASKMAX(kt, A0, A1) \
        __builtin_amdgcn_sched_barrier(0); \
        bf16x8 va[4], vb[4], ka[4], kb[4]; \
        VRD4(va, pst, 0); KRD4(ka, nst, 0); \
        PV4(va, 0, PKP); VRD4(vb, pst, 1); \
        QK4A(ka, B0, B1); KRD4(kb, nst, 1); \
        ATT_EXP(A0, A1, PKN) \
        PV4(vb, 1, PKP); VRD4(va, pst, 2); \
        QK4B(kb, B0, B1); \
        PV4(va, 2, PKP); VRD4(vb, pst, 3); \
        PV4(vb, 3, PKP); \
        PIN(PKN); \
        __builtin_amdgcn_sched_barrier(0); \
        TAIL(); } while (0)
    ATT_DMA(0, lds); ATT_DMA(1, lds + 32768);
    asm volatile("" :: "v"(qf[0]), "v"(qf[1]), "v"(qf[2]), "v"(qf[3]));
    __syncthreads();
    f32x16 zero16;
#pragma unroll
    for (int i = 0; i < 16; ++i) zero16[i] = 0.f;
    f32x16 S0, S1, N0, N1; u32x4 pkb[4];
    { bf16x8 ka[4], kb[4]; KRD4(ka, lds, 0); KRD4(kb, lds, 1); QK4A(ka, S0, S1); QK4B(kb, S0, S1); }
    asm volatile("s_nop 15\n\ts_nop 7" : "+v"(S0), "+v"(S1));
    {
        if (2 < nkt) ATT_DMA(2, lds + 2 * 32768);
        ATT_MASKMAX(0, S0, S1)
        const LAS unsigned char* nst = lds + 32768;
        __builtin_amdgcn_sched_barrier(0);
        bf16x8 ka[4], kb[4]; KRD4(ka, nst, 0); KRD4(kb, nst, 1);
        QK4A(ka, N0, N1);
        ATT_EXP(S0, S1, pk)
        QK4B(kb, N0, N1);
        PIN(pk);
        __builtin_amdgcn_sched_barrier(0);
        TAIL();
    }
#pragma unroll 1
    for (int kt = 1; kt + 1 < nkt; kt += 2) {
        ATT_ITER(kt, N0, N1, S0, S1, pk, pkb);
        ATT_ITER(kt + 1, S0, S1, N0, N1, pkb, pk);
    }
    {
        const int kt = nkt - 1;
        const LAS unsigned char* pst = lds + ((kt + 3) & 3) * 32768;
        ATT_MASKMAX(kt, N0, N1)
        __builtin_amdgcn_sched_barrier(0);
        bf16x8 va[4], vb[4];
        VRD4(va, pst, 0); VRD4(vb, pst, 1);
        PV4(va, 0, pk);
        ATT_EXP(N0, N1, pkb)
        PV4(vb, 1, pk); VRD4(va, pst, 2); VRD4(vb, pst, 3);
        PV4(va, 2, pk); PV4(vb, 3, pk);
        PIN(pkb);
        __builtin_amdgcn_sched_barrier(0);
        TAIL();
        const LAS unsigned char* lst = lds + (kt & 3) * 32768;
        VRD4(va, lst, 0); VRD4(vb, lst, 1); PV4(va, 0, pkb); PV4(vb, 1, pkb); VRD4(va, lst, 2); VRD4(vb, lst, 3); PV4(va, 2, pkb); PV4(vb, 3, pkb);
    }
    __syncthreads();
#undef VRD4
#undef KRD4
#undef PV4
#undef QK4A
#undef QK4B
#undef PIN
#undef TAIL
#undef ATT_ITER
#undef ATT_DMA
#undef ATT_MASKMAX
#undef ATT_EXP
    u32x4 gpre[8];
    if (c == 0) {
#pragma unroll
        for (int rep = 0; rep < 8; ++rep) { const int p = lane + 64 * rep, row = p >> 4, c16 = p & 15;
            gpre[rep] = *(const u32x4*)(Z + (tok0 + q0 + 32 * wq + row) * ZP + h * 128 + c16 * 8 + C_AGATE); }
    }
    lsum += __shfl_xor(lsum, 32);
    const float inv = 1.f / lsum;
    LAS float* ox = (LAS float*)lds + wq * 4096;
    if (c == 1) {
#pragma unroll
        for (int d = 0; d < 4; ++d)
#pragma unroll
            for (int i = 0; i < 16; ++i) ox[(32 * d + crow(i, hh)) * 32 + l31] = O[d][i] * inv;
    }
    __syncthreads();
    if (c == 0) {
        float ss = 0.f;
#pragma unroll
        for (int d = 0; d < 4; ++d)
#pragma unroll
            for (int i = 0; i < 16; ++i) { const float o = O[d][i] * inv - lam * ox[(32 * d + crow(i, hh)) * 32 + l31]; O[d][i] = o; ss += o * o; }
        ss += __shfl_xor(ss, 32);
        const float rn = rsqrtf(ss * (1.f / 128.f) + 1e-6f) * oml;
        LAS bf16_t* TO = (LAS bf16_t*)(lds + 65536 + wq * 8704);
#pragma unroll
        for (int d = 0; d < 4; ++d)
#pragma unroll
            for (int g4 = 0; g4 < 4; ++g4) { const int dv0 = 32 * d + 8 * g4 + 4 * hh; const f32x4 sg = *(const f32x4*)(subg + dv0);
                u32x2 w; w.x = pk2(O[d][4 * g4] * rn * sg[0], O[d][4 * g4 + 1] * rn * sg[1]); w.y = pk2(O[d][4 * g4 + 2] * rn * sg[2], O[d][4 * g4 + 3] * rn * sg[3]);
                *(LAS u32x2*)(TO + l31 * 136 + dv0) = w; }
        asm volatile("s_waitcnt lgkmcnt(0)" ::: "memory");
#pragma unroll
        for (int rep = 0; rep < 8; ++rep) { const int p = lane + 64 * rep, row = p >> 4, c16 = p & 15;
            const u32x4 ov = *(const LAS u32x4*)(TO + row * 136 + c16 * 8);
            bf16_t* zp = Z + (tok0 + q0 + 32 * wq + row) * ZP + h * 128 + c16 * 8;
            const u32x4 gt = gpre[rep];
            u32x4 w; w.x = pk2(bflo(ov.x) * siluf(bflo(gt.x)), bfhi(ov.x) * siluf(bfhi(gt.x))); w.y = pk2(bflo(ov.y) * siluf(bflo(gt.y)), bfhi(ov.y) * siluf(bfhi(gt.y)));
            w.z = pk2(bflo(ov.z) * siluf(bflo(gt.z)), bfhi(ov.z) * siluf(bfhi(gt.z))); w.w = pk2(bflo(ov.w) * siluf(bflo(gt.w)), bfhi(ov.w) * siluf(bfhi(gt.w)));
            if (ST) *(u32x4*)(zp + C_Q) = w; else *(LAS u32x4*)(lds + 139264 + lane * 16) = w; }
    }
    __syncthreads();
}

#define XB_TMO      128
#define XB_XCNT(j)  (256  + 64 * (j))
#define XB_XSUB(j)  (1280 + 64 * (j))
#define XB_XGEN(j)  (2304 + 64 * (j))
#define XB_TOP      3328
#define XB_TOPGEN   3392
#define XCD_BAR_WORDS 3456
#define XB_SPIN_CAP (1u << 22)
__device__ __forceinline__ unsigned xb_ld(unsigned* p)              { return __hip_atomic_load(p, __ATOMIC_RELAXED, __HIP_MEMORY_SCOPE_AGENT); }
__device__ __forceinline__ unsigned xb_add(unsigned* p, unsigned v) { return __hip_atomic_fetch_add(p, v, __ATOMIC_RELAXED, __HIP_MEMORY_SCOPE_AGENT); }
__device__ __forceinline__ unsigned xb_xcc_id() { return (unsigned)__builtin_amdgcn_s_getreg((3 << 11) | 20) & 0xFu; }
#define XB_SPIN(cond, bar) do { unsigned _sp = 0; while (cond) { __builtin_amdgcn_s_sleep(1); \
    if ((++_sp & 255u) == 0u) { if (xb_ld(&(bar)[XB_TMO])) break; if (_sp > XB_SPIN_CAP) { atomicAdd(&(bar)[XB_TMO], 1u); break; } } } } while (0)
struct XcdBarrier { unsigned* bar; unsigned x; volatile LAS unsigned* st; };
__device__ __forceinline__ XcdBarrier xcd_barrier_post(unsigned* bar, volatile LAS unsigned* st) {
    XcdBarrier b; b.bar = bar; b.x = xb_xcc_id(); b.st = st;
    if (threadIdx.x == 0) (void)xb_add(&bar[XB_XCNT(b.x)], 1u);
    return b;
}
__device__ __forceinline__ void xcd_barrier_complete(unsigned* bar, unsigned x, unsigned& nloc, unsigned& nx) {
    const unsigned G = gridDim.x * gridDim.y * gridDim.z;
    unsigned sum, cnt, mine, sp = 0u;
    for (;;) {
        sum = 0u; cnt = 0u; mine = 0u;
#pragma unroll
        for (unsigned j = 0; j < 16; ++j) { const unsigned c = xb_ld(&bar[XB_XCNT(j)]); sum += c; cnt += (c > 0u) ? 1u : 0u; mine = (j == x) ? c : mine; }
        if (sum == G) break;
        __builtin_amdgcn_s_sleep(1);
        if ((++sp & 255u) == 0u) { if (xb_ld(&bar[XB_TMO])) break; if (sp > XB_SPIN_CAP) { atomicAdd(&bar[XB_TMO], 1u); break; } }
    }
    nloc = mine > 0u ? mine : 1u; nx = cnt > 0u ? cnt : 1u;
}
__device__ __forceinline__ void xcd_barrier(const XcdBarrier& b) {
    asm volatile("s_waitcnt vmcnt(0)" ::: "memory");
    __syncthreads();
    if (threadIdx.x == 0) {
        unsigned* bar = b.bar;
        __builtin_amdgcn_s_waitcnt(0);
        unsigned nloc = b.st[0], nx = b.st[1];
        if (nloc == 0u) { xcd_barrier_complete(bar, b.x, nloc, nx); b.st[0] = nloc; b.st[1] = nx; }
        const unsigned old = xb_add(&bar[XB_XSUB(b.x)], 1u);
        const unsigned gen = old / nloc;
        if (old + 1u == (gen + 1u) * nloc) {
            __builtin_amdgcn_fence(__ATOMIC_RELEASE, "agent");
            asm volatile("s_waitcnt vmcnt(0)" ::: "memory");
            const unsigned og = xb_add(&bar[XB_TOP], 1u);
            const unsigned tg = og / nx;
            if (og + 1u == (tg + 1u) * nx) xb_add(&bar[XB_TOPGEN], 1u);
            else XB_SPIN(xb_ld(&bar[XB_TOPGEN]) == tg, bar);
            __builtin_amdgcn_fence(__ATOMIC_ACQUIRE, "agent");
            xb_add(&bar[XB_XGEN(b.x)], 1u);
            asm volatile("s_waitcnt vmcnt(0)" ::: "memory");
        } else {
            XB_SPIN(xb_ld(&bar[XB_XGEN(b.x)]) == gen, bar);
            __builtin_amdgcn_fence(__ATOMIC_ACQUIRE, "agent");
            asm volatile("s_waitcnt vmcnt(0)" ::: "memory");
        }
    }
    __syncthreads();
}
struct Params { const float* in[24]; float* out; unsigned char* ws; };

__global__ void __launch_bounds__(512, 2) mega_fwd(Params P) {
    extern __shared__ __attribute__((aligned(16))) unsigned char lds_raw[];
    LAS unsigned char* lds = (LAS unsigned char*)lds_raw;
    cg::grid_group grid = cg::this_grid();
    const int tid = threadIdx.x, lane = tid & 63, wid = __builtin_amdgcn_readfirstlane(tid >> 6);
    const int G = gridDim.x, bx = blockIdx.x;
    const int vcu = (G % 8 == 0) ? (bx % 8) * (G / 8) + bx / 8 : bx;
    const int gw = vcu * 8 + wid, NGW = G * 8;
    unsigned char* ws = P.ws;
    bf16_t* Z = (bf16_t*)(ws + OFF_Z); bf16_t* VT = (bf16_t*)(ws + OFF_VT); bf16_t* XB = (bf16_t*)(ws + OFF_XB);
    bf16_t* WinT = (bf16_t*)(ws + OFF_WIN); bf16_t* WoutT = (bf16_t*)(ws + OFF_WOUT); bf16_t* GluT = (bf16_t*)(ws + OFF_GLU);
    bf16_t* KC = (bf16_t*)(ws + OFF_KC); bf16_t* CCH = (bf16_t*)(ws + OFF_CCH); bf16_t* BCH = (bf16_t*)(ws + OFF_BCH); float* A16 = (float*)(ws + OFF_A16);
    float* part = (float*)(ws + OFF_PART); bf16_t* SGUW = (bf16_t*)(ws + OFF_SGUW); float* LAM = (float*)(ws + OFF_LAM);
    const float* x_in = P.in[0];
    unsigned* barw = (unsigned*)(ws + OFF_BAR);
    volatile LAS unsigned* bst = (volatile LAS unsigned*)(lds + LDS_BYTES - 16);
    if (tid == 0) { bst[0] = 0u; bst[1] = 0u; }
    __syncthreads();
    XcdBarrier xbar = xcd_barrier_post(barw, bst);
    if (P.ws == nullptr) grid.sync();
#define GSYNC() xcd_barrier(xbar)

#ifdef PROBE_P0X2
    for (int rep_ = 0; rep_ < 2; ++rep_) {
#else
    {
#endif
    conv_win(lds, P.in[2], P.in[1], WinT, gw, NGW, wid, lane);
    conv_plain(lds, P.in[11], 512, 512, GluT, gw, NGW, wid, lane);
    conv_plain(lds, P.in[11] + 512 * 512, 512, 512, GluT + 512 * 512, gw, NGW, wid, lane);
    __syncthreads();
#ifndef SKIP_S5P
    { S5In I{P.in[3], P.in[4], P.in[5], P.in[6], P.in[7], P.in[8], P.in[9], P.in[10]};
      for (int lg = vcu; lg < 64; lg += G) s5_params(lds, I, lg, KC, CCH, BCH, A16, tid); }
#endif
    for (int i = vcu * 512 + tid; i < 2 * 4 * 16384; i += G * 512) { const int t = (i >> 7) & 127, s = i & 127; SGUW[i] = f2bf(s <= t ? P.in[15][i] : 0.f); }
    if (bx == 0 && tid < 2) { const int l = tid; float d1 = 0.f, d2 = 0.f;
        for (int i = 0; i < 64; ++i) { d1 += P.in[17][l * 64 + i] * P.in[18][l * 64 + i]; d2 += P.in[19][l * 64 + i] * P.in[20][l * 64 + i]; }
        const float li = 0.8f - 0.6f * expf(-0.3f * (float)l); LAM[2 * l] = expf(d1) - expf(d2) + li; LAM[2 * l + 1] = 1.f - li; }
    for (int r0 = gw; r0 < T_TOK; r0 += 4 * NGW) {
        f32x4 v[4][4];
#pragma unroll
        for (int q = 0; q < 4; ++q) { const int r = r0 + q * NGW; if (r < T_TOK) { const f32x4* xr = (const f32x4*)(x_in + (size_t)r * DM) + lane;
#pragma unroll
            for (int j = 0; j < 4; ++j) v[q][j] = __builtin_nontemporal_load(xr + 64 * j); } }
#pragma unroll
        for (int q = 0; q < 4; ++q) { const int r = r0 + q * NGW; if (r < T_TOK) { float s = 0.f; u32x2* xo = (u32x2*)(XB + (size_t)r * DM) + lane;
#pragma unroll
            for (int j = 0; j < 4; ++j) { const f32x4 t = v[q][j]; s += (t[0] * t[0] + t[1] * t[1]) + (t[2] * t[2] + t[3] * t[3]); u32x2 w; w.x = pk2(t[0], t[1]); w.y = pk2(t[2], t[3]); xo[64 * j] = w; }
            s = wave_sum(s);
            if (lane < 16) part[(size_t)r * 16 + lane] = (lane == 0) ? s : 0.f; } }
    }
    __syncthreads();
    }
    GSYNC();

    for (int l = 0; l < 2; ++l) {
        conv_plain(lds, P.in[22] + (size_t)l * 2048 * 1024, 2048, 1024, WoutT, gw, NGW, wid, lane);
        __syncthreads();
        { pg8::Gemm g{XB, WinT, T_TOK, ZP, 1024, 1024, 1024}; pg8::StaticOrder S; S.init(T_TOK, ZP, G, bx); EpiIn E{Z, part};
          pg8::gemm_phase<EpiIn>(lds, g, S, E); }
#ifdef PROBE_P1X2
        { pg8::Gemm g{XB, WinT, T_TOK, ZP, 1024, 1024, 1024}; pg8::StaticOrder S; S.init(T_TOK, ZP, G, bx); EpiIn E{Z, part};
          pg8::gemm_phase<EpiIn>(lds, g, S, E); }
#endif
        { pg8::Gemm g{WinT + (size_t)ZP * 1024, XB, 1024, T_TOK, 1024, 1024, 1024}; pg8::StaticOrder S; S.init(1024, T_TOK, G, bx); EpiVT E{VT, part};
          pg8::gemm_phase<EpiVT>(lds, g, S, E); }
#ifdef PROBE_VTX2
        { pg8::Gemm g{WinT + (size_t)ZP * 1024, XB, 1024, T_TOK, 1024, 1024, 1024}; pg8::StaticOrder S; S.init(1024, T_TOK, G, bx); EpiVT E{VT, part};
          pg8::gemm_phase<EpiVT>(lds, g, S, E); }
#endif
        GSYNC();
#ifndef SKIP_S5
        for (int u = vcu; u < 256; u += G) { const int b = u >> 5, g = u & 31, lg = l * 32 + g;
            s5_unit<true>(lds, Z, KC + (size_t)lg * 4096, CCH + (size_t)lg * 32768, BCH + (size_t)lg * 32768, A16 + lg * 128, b, g, wid, lane); }
#endif
        {
          int nmine = 0; for (int u = vcu; u < 256; u += G) ++nmine;
          asm volatile("s_waitcnt vmcnt(0)" ::: "memory"); __syncthreads();
          if (tid == 0) { __builtin_amdgcn_fence(__ATOMIC_RELEASE, "agent"); asm volatile("s_waitcnt vmcnt(0)" ::: "memory");
              __hip_atomic_fetch_add(barw + 3600 + 64 * l, (unsigned)nmine, __ATOMIC_RELAXED, __HIP_MEMORY_SCOPE_AGENT); } }
#ifndef SKIP_SGU
        for (int u = vcu; u < 1024; u += G) { const int hd = u & 3, ch = (u >> 2) & 31, b = u >> 7;
            sgu_unit<true>(lds, Z, SGUW + (size_t)l * 65536, P.in[13] + l * 512, P.in[14] + l * 512, P.in[16] + l * 512, b, ch, hd, wid, lane); }
#endif
#ifdef PROBE_MIX2
        for (int u = vcu; u < 256; u += G) { const int b = u >> 5, g = u & 31, lg = l * 32 + g;
            s5_unit<false>(lds, Z, KC + (size_t)lg * 4096, CCH + (size_t)lg * 32768, BCH + (size_t)lg * 32768, A16 + lg * 128, b, g, wid, lane); }
        for (int u = vcu; u < 1024; u += G) { const int hd = u & 3, ch = (u >> 2) & 31, b = u >> 7;
            sgu_unit<false>(lds, Z, SGUW + (size_t)l * 65536, P.in[13] + l * 512, P.in[14] + l * 512, P.in[16] + l * 512, b, ch, hd, wid, lane); }
#endif
        { const float lam = LAM[2 * l], oml = LAM[2 * l + 1]; const float* subg = P.in[21] + l * 128;
#ifndef SKIP_ATT
          for (int u = vcu; u < 1024; u += G) { const int bh = u >> 4, pr = u & 15, b = bh >> 3, h = bh & 7;
              attn_qblock<true>(lds, Z, VT, b, h, 31 - pr, lam, oml, subg, tid, wid, lane);
              attn_qblock<true>(lds, Z, VT, b, h, pr, lam, oml, subg, tid, wid, lane); }
#endif
#ifdef PROBE_ATT2
          for (int u = vcu; u < 1024; u += G) { const int bh = u >> 4, pr = u & 15, b = bh >> 3, h = bh & 7;
              attn_qblock<false>(lds, Z, VT, b, h, 31 - pr, lam, oml, subg, tid, wid, lane);
              attn_qblock<false>(lds, Z, VT, b, h, pr, lam, oml, subg, tid, wid, lane); }
#endif
        }
        { asm volatile("s_waitcnt vmcnt(0)" ::: "memory"); __syncthreads();
          if (tid == 0) { unsigned sp = 0; while (__hip_atomic_load(barw + 3600 + 64 * l, __ATOMIC_RELAXED, __HIP_MEMORY_SCOPE_AGENT) < 256u) { __builtin_amdgcn_s_sleep(2); if (++sp > (1u << 24)) break; }
              __builtin_amdgcn_fence(__ATOMIC_ACQUIRE, "agent"); asm volatile("s_waitcnt vmcnt(0)" ::: "memory"); }
          __syncthreads(); }
        { pg8::Gemm g{Z + C_SIN, GluT + (size_t)l * 512 * 512, T_TOK, 512, 512, ZP, 512}; pg8::StaticOrder S; S.init(T_TOK, 512, G, bx); EpiGlu E{Z, P.in[12] + l * 512};
          pg8::gemm_phase<EpiGlu>(lds, g, S, E); }
        if (l == 0) { __syncthreads(); conv_win(lds, P.in[2] + (size_t)1024 * NIN, P.in[1] + 1024, WinT, gw, NGW, wid, lane); __syncthreads(); }
        GSYNC();
        if (l == 0) { pg8::Gemm g{Z, WoutT, T_TOK, DM, DMIX, ZP, DMIX}; pg8::StaticOrder S; S.init(T_TOK, DM, G, bx); EpiOut<false> E{x_in, P.out, XB, part};
          pg8::gemm_phase<EpiOut<false>>(lds, g, S, E); }
        else { pg8::Gemm g{Z, WoutT, T_TOK, DM, DMIX, ZP, DMIX}; pg8::StaticOrder S; S.init(T_TOK, DM, G, bx); EpiOut<true> E{P.out, P.out, XB, part};
          pg8::gemm_phase<EpiOut<true>>(lds, g, S, E); }
        GSYNC();
    }
#ifdef PROBE_SYNC20
    for (int i = 0; i < 20; ++i) GSYNC();
#endif
    for (int r0 = gw; r0 < T_TOK; r0 += 4 * NGW) {
        f32x4 v[4][4]; float ri[4];
#pragma unroll
        for (int q = 0; q < 4; ++q) { const int r = r0 + q * NGW; if (r < T_TOK) { ri[q] = row_rinv(part, r); const f32x4* xr = (const f32x4*)(P.out + (size_t)r * DM) + lane;
#pragma unroll
            for (int j = 0; j < 4; ++j) v[q][j] = xr[64 * j]; } }
        const f32x4* gg = (const f32x4*)P.in[23] + lane;
#pragma unroll
        for (int q = 0; q < 4; ++q) { const int r = r0 + q * NGW; if (r < T_TOK) { f32x4* xr = (f32x4*)(P.out + (size_t)r * DM) + lane;
#pragma unroll
            for (int j = 0; j < 4; ++j) __builtin_nontemporal_store(v[q][j] * ri[q] * gg[64 * j], xr + 64 * j); } }
    }
}

extern "C" void kernel_launch(void* const* d_in, const int* in_sizes, int n_in, void* d_out, int out_size, void* d_ws, size_t ws_size, hipStream_t stream) {
    static int grid_blocks = 0;
    if (!grid_blocks) {
        if (n_in != 24 || ws_size < WS_END) { fprintf(stderr, "kernel_launch: unexpected n_in %d / ws_size %zu (need %zu)\n", n_in, ws_size, (size_t)WS_END); grid_blocks = -1; return; }
        int dev = 0, cus = 0, per_cu = 0;
        hipGetDevice(&dev);
        hipDeviceGetAttribute(&cus, hipDeviceAttributeMultiprocessorCount, dev);
        hipFuncSetAttribute((const void*)mega_fwd, hipFuncAttributeMaxDynamicSharedMemorySize, LDS_BYTES);
        hipOccupancyMaxActiveBlocksPerMultiprocessor(&per_cu, (const void*)mega_fwd, 512, LDS_BYTES);
        if (per_cu < 1) { fprintf(stderr, "kernel_launch: occupancy query says %d blocks/CU\n", per_cu); per_cu = 1; }
        grid_blocks = cus * 1;
    }
    if (grid_blocks < 0) return;
    if (hipMemsetAsync((char*)d_ws + OFF_BAR, 0, 16384, stream) != hipSuccess) { fprintf(stderr, "kernel_launch: memset of the barrier words failed\n"); return; }
    Params p{};
    for (int i = 0; i < 24; ++i) p.in[i] = (const float*)d_in[i];
    p.out = (float*)d_out; p.ws = (unsigned char*)d_ws;
    void* args[] = {&p};
    hipError_t e = hipLaunchCooperativeKernel((const void*)mega_fwd, dim3(grid_blocks), dim3(512), args, LDS_BYTES, stream);
    if (e != hipSuccess) fprintf(stderr, "cooperative launch failed: %s (grid %d)\n", hipGetErrorString(e), grid_blocks);
}
```
